# Optimizing an MI355X kernel written in HIP

```python
import math
import jax, jax.numpy as jnp
from jax import lax
import numpy as np

D_MODEL = 2048
BATCH = 4
SEQ = 2048
DEPTH = 4

GRID_W = 64
CTX_LEN = 256
N_BRANCH = 3
ATT_HEADS = D_MODEL // 256
ATT_HEAD_DIM = 64
ATT_V_DIM = 2 * ATT_HEAD_DIM
ATT_WIDTH = ATT_HEADS * 2 * ATT_HEAD_DIM
ROPE_BASE = 10000.0
Q_BLOCK = 128
HY_WIDTH = D_MODEL // 4
HY_ORDER = 2
HY_BANDS = 16
HY_EMB_DIM = 1 + 2 * HY_BANDS
HY_FILTER_DIM = 64
HY_MIN_DECAY = math.log(1e-2) / 1.5
HY_MAX_DECAY = math.log(1e-2) / 0.3
POOL_WINDOWS = (2, 4, 8, 16)
POOL_GROUPS = len(POOL_WINDOWS)
POOL_WIDTH = D_MODEL // 4
POOL_GROUP_DIM = POOL_WIDTH // POOL_GROUPS
IN_SPLITS = (ATT_WIDTH, 2 * ATT_WIDTH, 3 * ATT_WIDTH, 3 * ATT_WIDTH + 3 * HY_WIDTH,
             3 * ATT_WIDTH + 3 * HY_WIDTH + POOL_WIDTH)
IN_WIDTH = 3 * ATT_WIDTH + 3 * HY_WIDTH + POOL_WIDTH + N_BRANCH * D_MODEL
FF_DIM = 5632
EPS = 1e-6

kernel_name = "hybrid_diffattn_hyena_pool_dit"

F32 = jnp.float32


def rmsnorm(x, g):
    xf = x.astype(F32)
    y = xf * lax.rsqrt(jnp.mean(xf * xf, axis=-1, keepdims=True) + EPS)
    return (y * g.astype(F32)).astype(x.dtype)


def dwconv3(x, w):
    xp = jnp.pad(x, ((0, 0), (1, 1), (0, 0)))
    return xp[:, :-2] * w[0] + xp[:, 1:-1] * w[1] + xp[:, 2:] * w[2]


def axial_rope(rows):
    row = jnp.repeat(jnp.arange(rows, dtype=F32), GRID_W)
    col = jnp.tile(jnp.arange(GRID_W, dtype=F32), rows)
    n_freq = ATT_HEAD_DIM // 4
    inv = ROPE_BASE ** (-jnp.arange(n_freq, dtype=F32) / n_freq)
    ang = jnp.stack([row[:, None] * inv, col[:, None] * inv], axis=1)
    return jnp.cos(ang), jnp.sin(ang)


def apply_rope(t, cos, sin):
    B, L, H, M, _ = t.shape
    tr = t.astype(F32).reshape(B, L, H, M, 2, 2, ATT_HEAD_DIM // 4)
    c = cos[None, :, None, None]
    s = sin[None, :, None, None]
    t1, t2 = tr[..., 0, :], tr[..., 1, :]
    out = jnp.stack([t1 * c - t2 * s, t2 * c + t1 * s], axis=-2)
    return out.reshape(t.shape).astype(t.dtype)


def heads_qk(t):
    B, L, _ = t.shape
    return t.reshape(B, L, ATT_HEADS, 2, ATT_HEAD_DIM)


def heads_v(t):
    B, L, _ = t.shape
    return t.reshape(B, L, ATT_HEADS, ATT_V_DIM)


def diff_lambda(lam_p, layer_idx):
    lam_init = 0.8 - 0.6 * math.exp(-0.3 * layer_idx)
    lp = lam_p.astype(F32)
    lam = jnp.exp(jnp.sum(lp[0] * lp[1])) - jnp.exp(jnp.sum(lp[2] * lp[3])) + lam_init
    return lam, lam_init


def diff_attend(q, k, v, lam):
    s = jnp.einsum('bqhmd,bkhmd->bhmqk', q, k).astype(F32) * (ATT_HEAD_DIM ** -0.5)
    p = jax.nn.softmax(s, axis=-1).astype(v.dtype)
    o = jnp.einsum('bhmqk,bkhe->bqhme', p, v)
    return o[:, :, :, 0] - lam.astype(o.dtype) * o[:, :, :, 1]


def blocked_diff_attention(q, k, v, lam):
    B, L = q.shape[0], q.shape[1]
    nb = L // Q_BLOCK
    qb = jnp.moveaxis(q.reshape(B, nb, Q_BLOCK, ATT_HEADS, 2, ATT_HEAD_DIM), 1, 0)
    ob = lax.map(lambda qq: diff_attend(qq, k, v, lam), qb)
    return jnp.moveaxis(ob, 0, 1).reshape(B, L, ATT_HEADS, ATT_V_DIM)


def hyena_filters(L, w1, b1, w2, b2, w3, freq):
    t = jnp.linspace(0.0, 1.0, L, dtype=F32)[:, None]
    w_ang = 2.0 * math.pi * jnp.arange(L, dtype=F32)[:, None] / L
    f = jnp.linspace(1e-4, HY_BANDS - 1, HY_BANDS, dtype=F32)[None, :]
    z = jnp.concatenate([t, jnp.cos(f * w_ang), -jnp.sin(f * w_ang)], axis=-1)
    fr = freq.astype(F32)
    h = jnp.sin(fr[0] * (z @ w1.astype(F32) + b1.astype(F32)))
    h = jnp.sin(fr[1] * (h @ w2.astype(F32) + b2.astype(F32)))
    h = (h @ w3.astype(F32)).reshape(L, 2, HY_ORDER, HY_WIDTH)
    deltas = jnp.abs(jnp.linspace(HY_MIN_DECAY, HY_MAX_DECAY, HY_WIDTH, dtype=F32))
    h = h * jnp.exp(-t * deltas[None, :])[:, None, None, :]
    fwd, bwd = h[:, 0], h[:, 1]
    k = jnp.concatenate([fwd, jnp.zeros((1, HY_ORDER, HY_WIDTH), F32), bwd[:0:-1]], axis=0)
    return k / (jnp.sum(jnp.abs(k), axis=0, keepdims=True) + EPS)


def fft_longconv(u, k, bias):
    L = u.shape[1]
    uf = jnp.fft.rfft(u.astype(F32), n=2 * L, axis=1)
    kf = jnp.fft.rfft(k, n=2 * L, axis=0)
    y = jnp.fft.irfft(uf * kf[None], n=2 * L, axis=1)[:, :L]
    return (y + u.astype(F32) * bias.astype(F32)).astype(u.dtype)


def hyena_mix(hy, short_w, filt, bias):
    hy = dwconv3(hy, short_w)
    v, x1, x2 = jnp.split(hy, 3, axis=-1)
    z = x1 * fft_longconv(v, filt[:, 0], bias[0])
    return x2 * fft_longconv(z, filt[:, 1], bias[1])


def pool_mix(p, pool_w, pool_scale):
    B, L, _ = p.shape
    pg = p.reshape(B, L, POOL_GROUPS, POOL_GROUP_DIM)
    t = jnp.arange(L)
    outs = []
    for g, win in enumerate(POOL_WINDOWS):
        xg = pg[:, :, g].astype(F32)
        cs = jnp.pad(jnp.cumsum(xg, axis=1), ((0, 0), (1, 0), (0, 0)))
        lo = jnp.clip(t - win // 2, 0, L)
        hi = jnp.clip(t + win - win // 2, 0, L)
        mean = (cs[:, hi] - cs[:, lo]) / (hi - lo).astype(F32)[None, :, None]
        outs.append((mean - xg).astype(p.dtype) @ pool_w[g])
    return jnp.concatenate(outs, axis=-1) * pool_scale


def mixer_branches(q, k_all, v_all, hy, pool, gates, lam, lam_init, filt, subln_g, hy_short_w, hy_bias,
                   pool_w, pool_scale, w_att_o, w_hy_o, w_pool_o, w_out):
    B, L = hy.shape[0], hy.shape[1]
    att = blocked_diff_attention(q, k_all, v_all, lam)
    att = (rmsnorm(att, subln_g) * (1.0 - lam_init)).reshape(B, L, ATT_WIDTH)
    hyo = hyena_mix(hy, hy_short_w, filt, hy_bias)
    poo = pool_mix(pool, pool_w, pool_scale)
    g_a, g_h, g_p = jnp.split(jax.nn.sigmoid(gates), N_BRANCH, axis=-1)
    merged = g_a * (att @ w_att_o) + g_h * (hyo @ w_hy_o) + g_p * (poo @ w_pool_o)
    return merged @ w_out


def conv_ffn(h, w_up, conv_w, w_down):
    gate, val = jnp.split(h @ w_up, 2, axis=-1)
    return (jax.nn.gelu(dwconv3(gate, conv_w)) * val) @ w_down


def setup_inputs(seed: int = 0) -> dict:
    key = jax.random.key(seed)
    ks = jax.random.split(key, 32)

    def nrm(k, shape, fan_in):
        return jax.random.normal(k, shape, F32) * (fan_in ** -0.5)

    def near_one(k, shape):
        return 1.0 + 0.02 * jax.random.normal(k, shape, F32)

    return {
        "x": jax.random.normal(ks[0], (BATCH, SEQ, D_MODEL), F32),
        "c": jax.random.normal(ks[1], (BATCH, D_MODEL), F32),
        "ctx": jax.random.normal(ks[2], (BATCH, CTX_LEN, D_MODEL), F32),
        "c_ctx": jax.random.normal(ks[3], (D_MODEL,), F32),
        "w_ada": nrm(ks[4], (DEPTH, D_MODEL, 6 * D_MODEL), D_MODEL),
        "b_ada": 0.02 * jax.random.normal(ks[5], (DEPTH, 6 * D_MODEL), F32),
        "norm_g": near_one(ks[6], (DEPTH, 4, D_MODEL)),
        "w_in": nrm(ks[7], (DEPTH, D_MODEL, IN_WIDTH), D_MODEL),
        "diff_lam": 0.1 * jax.random.normal(ks[8], (DEPTH, 4, ATT_HEAD_DIM), F32),
        "attn_subln_g": near_one(ks[9], (DEPTH, ATT_V_DIM)),
        "hy_short_w": nrm(ks[10], (DEPTH, 3, 3 * HY_WIDTH), 3),
        "hy_ffn_w1": nrm(ks[11], (DEPTH, HY_EMB_DIM, HY_FILTER_DIM), HY_EMB_DIM),
        "hy_ffn_b1": 0.1 * jax.random.normal(ks[12], (DEPTH, HY_FILTER_DIM), F32),
        "hy_ffn_w2": nrm(ks[13], (DEPTH, HY_FILTER_DIM, HY_FILTER_DIM), HY_FILTER_DIM),
        "hy_ffn_b2": 0.1 * jax.random.normal(ks[14], (DEPTH, HY_FILTER_DIM), F32),
        "hy_ffn_w3": nrm(ks[15], (DEPTH, HY_FILTER_DIM, 2 * HY_ORDER * HY_WIDTH), HY_FILTER_DIM),
        "hy_freq": near_one(ks[16], (DEPTH, 2, HY_FILTER_DIM)),
        "hy_bias": 0.5 * jax.random.normal(ks[17], (DEPTH, HY_ORDER, HY_WIDTH), F32),
        "pool_w": nrm(ks[18], (DEPTH, POOL_GROUPS, POOL_GROUP_DIM, POOL_GROUP_DIM), POOL_GROUP_DIM),
        "pool_scale": near_one(ks[19], (DEPTH, POOL_WIDTH)),
        "w_att_o": nrm(ks[20], (DEPTH, ATT_WIDTH, D_MODEL), ATT_WIDTH),
        "w_hy_o": nrm(ks[21], (DEPTH, HY_WIDTH, D_MODEL), HY_WIDTH),
        "w_pool_o": nrm(ks[22], (DEPTH, POOL_WIDTH, D_MODEL), POOL_WIDTH),
        "w_out": nrm(ks[23], (DEPTH, D_MODEL, D_MODEL), D_MODEL),
        "w_up": nrm(ks[24], (DEPTH, D_MODEL, 2 * FF_DIM), D_MODEL),
        "ff_conv_w": nrm(ks[25], (DEPTH, 3, FF_DIM), 3),
        "w_down": nrm(ks[26], (DEPTH, FF_DIM, D_MODEL), FF_DIM),
    }


def reference(x, c, ctx, c_ctx, w_ada, b_ada, norm_g, w_in, diff_lam, attn_subln_g, hy_short_w,
              hy_ffn_w1, hy_ffn_b1, hy_ffn_w2, hy_ffn_b2, hy_ffn_w3, hy_freq, hy_bias, pool_w, pool_scale,
              w_att_o, w_hy_o, w_pool_o, w_out, w_up, ff_conv_w, w_down):
    L = x.shape[1]
    LC = ctx.shape[1]
    ROWS = L // GRID_W
    cos, sin = axial_rope(ROWS)
    silu_c = jax.nn.silu(c)
    silu_cc = jax.nn.silu(c_ctx)
    for l in range(DEPTH):
        last = l == DEPTH - 1
        m_x = [m[:, None, :] for m in jnp.split(silu_c @ w_ada[l] + b_ada[l], 6, axis=-1)]
        m_c = jnp.split(silu_cc @ w_ada[l] + b_ada[l], 6, axis=-1)
        lam, lam_init = diff_lambda(diff_lam[l], l)
        filt_x = hyena_filters(L, hy_ffn_w1[l], hy_ffn_b1[l], hy_ffn_w2[l], hy_ffn_b2[l], hy_ffn_w3[l], hy_freq[l])

        hx = rmsnorm(x, norm_g[l, 0]) * (1.0 + m_x[1]) + m_x[0]
        hc = rmsnorm(ctx, norm_g[l, 0]) * (1.0 + m_c[1]) + m_c[0]
        if last:
            k_c, v_c = jnp.split(hc @ w_in[l][:, ATT_WIDTH:3 * ATT_WIDTH], 2, axis=-1)
        else:
            q_c, k_c, v_c, hy_c, pool_c, gate_c = jnp.split(hc @ w_in[l], IN_SPLITS, axis=-1)
        k_c = heads_qk(k_c)
        v_c = heads_v(v_c)

        q_x, k_x, v_x, hy_x, pool_x, gate_x = jnp.split(hx @ w_in[l], IN_SPLITS, axis=-1)
        q_x = apply_rope(heads_qk(q_x), cos, sin)
        k_x = apply_rope(heads_qk(k_x), cos, sin)
        k_all = jnp.concatenate([k_x, k_c], axis=1)
        v_all = jnp.concatenate([heads_v(v_x), v_c], axis=1)
        mix_x = mixer_branches(q_x, k_all, v_all, hy_x, pool_x, gate_x, lam, lam_init, filt_x,
                               attn_subln_g[l], hy_short_w[l], hy_bias[l], pool_w[l], pool_scale[l],
                               w_att_o[l], w_hy_o[l], w_pool_o[l], w_out[l])
        x = x + m_x[2] * rmsnorm(mix_x, norm_g[l, 1])

        h2 = rmsnorm(x, norm_g[l, 2]) * (1.0 + m_x[4]) + m_x[3]
        x = x + m_x[5] * rmsnorm(conv_ffn(h2, w_up[l], ff_conv_w[l], w_down[l]), norm_g[l, 3])

        if not last:
            filt_c = hyena_filters(LC, hy_ffn_w1[l], hy_ffn_b1[l], hy_ffn_w2[l], hy_ffn_b2[l], hy_ffn_w3[l], hy_freq[l])
            mix_c = mixer_branches(heads_qk(q_c), k_c, v_c, hy_c, pool_c, gate_c, lam, lam_init, filt_c,
                                   attn_subln_g[l], hy_short_w[l], hy_bias[l], pool_w[l], pool_scale[l],
                                   w_att_o[l], w_hy_o[l], w_pool_o[l], w_out[l])
            ctx = ctx + m_c[2] * rmsnorm(mix_c, norm_g[l, 1])
            hc2 = rmsnorm(ctx, norm_g[l, 2]) * (1.0 + m_c[4]) + m_c[3]
            ctx = ctx + m_c[5] * rmsnorm(conv_ffn(hc2, w_up[l], ff_conv_w[l], w_down[l]), norm_g[l, 3])
    return x
```

```cpp
#include <hip/hip_runtime.h>
#include <cstdio>
#include <cstdint>
#define GAS __attribute__((address_space(1)))
#define LAS __attribute__((address_space(3)))
typedef unsigned short bf16;
typedef float f32x4 __attribute__((ext_vector_type(4)));
typedef float f32x2 __attribute__((ext_vector_type(2)));
typedef float f32x16 __attribute__((ext_vector_type(16)));
typedef unsigned u32x4 __attribute__((ext_vector_type(4)));
typedef unsigned u32x2 __attribute__((ext_vector_type(2)));
typedef short bf16x8 __attribute__((ext_vector_type(8)));
typedef short s16x4 __attribute__((ext_vector_type(4)));
typedef __bf16 bf16x2_t __attribute__((ext_vector_type(2)));

constexpr int DM = 2048, NBATCH = 4, SEQ = 2048, DEPTH = 4, CTX = 256;
constexpr int RX = NBATCH * SEQ, RC = NBATCH * CTX, RT = RX + RC;
constexpr int INW = 11264, FF = 5632, AW = 1024, HWD = 512, PWD = 512;
constexpr int NQKV = 3072, NGT = 6144;
constexpr float EPS = 1e-6f;
constexpr float QSCALE = 0.125f * 1.4426950408889634f;
constexpr int NWAVES = 8, NTHR = 512;

constexpr size_t al256(size_t x) { return (x + 255) & ~(size_t)255; }
constexpr size_t WS_CTL = 0, CTL_BYTES = 1u << 20, CTL_ZERO = 64u << 10;
constexpr size_t SZ_WIN = (size_t)INW * DM * 2, SZ_WUP = SZ_WIN, SZ_WDN = (size_t)DM * FF * 2, SZ_WOUT = (size_t)DM * DM * 2;
constexpr size_t SZ_WAO = (size_t)DM * AW * 2, SZ_WHO = (size_t)DM * HWD * 2, SZ_WPO = (size_t)DM * PWD * 2, SZ_PWT = 4 * 128 * 128 * 2;
constexpr size_t LW_WIN = 0, LW_WUP = LW_WIN + SZ_WIN, LW_WDN = LW_WUP + SZ_WUP, LW_WOUT = LW_WDN + SZ_WDN, LW_WAO = LW_WOUT + SZ_WOUT,
                 LW_WHO = LW_WAO + SZ_WAO, LW_WPO = LW_WHO + SZ_WHO, LW_PWT = LW_WPO + SZ_WPO, LW_SIZE = LW_PWT + SZ_PWT;
constexpr size_t WS_W = CTL_BYTES;
constexpr size_t WS_ADA = WS_W + DEPTH * LW_SIZE;
constexpr size_t WS_KF = al256(WS_ADA + (size_t)DEPTH * 5 * 12288 * 4);
constexpr size_t WS_KFC = WS_KF + (size_t)DEPTH * 2 * 512 * 4096 * 4;
constexpr size_t WS_ROPE = WS_KFC + (size_t)DEPTH * 2 * 512 * 512 * 4;
constexpr size_t WS_SC = WS_ROPE + 8192;
constexpr size_t WS_XRES = al256(WS_SC + 256);
constexpr size_t WS_H = WS_XRES + (size_t)RT * DM * 4;
constexpr size_t WS_QKV = WS_H + (size_t)RT * DM * 2;
constexpr size_t WS_HYT = WS_QKV + (size_t)RT * NQKV * 2;
constexpr size_t WS_PL = WS_HYT + (size_t)1536 * RT * 2;
constexpr size_t WS_GT = WS_PL + (size_t)RT * 512 * 2;
constexpr size_t WS_UP = WS_QKV;
constexpr size_t WS_EG = WS_UP;
constexpr size_t WS_EV = WS_EG + (size_t)144 * 4 * FF * 2;
constexpr size_t WS_MIXA = WS_GT + (size_t)RT * NGT * 2;
constexpr size_t WS_M32 = WS_MIXA + (size_t)RT * DM * 2;
constexpr size_t WS_MERGED = WS_M32 + (size_t)RT * DM * 4;
constexpr size_t WS_ACT = WS_M32;
constexpr size_t WS_MIX = WS_MERGED + (size_t)RT * DM * 2;
constexpr size_t WS_SLAB = WS_MIX + (size_t)RT * DM * 2;
constexpr size_t WS_END = WS_SLAB + (size_t)8 * RC * DM * 4;
static_assert(WS_UP + (size_t)RT * INW * 2 <= WS_MIXA, "UP overlay");
static_assert(WS_ACT + (size_t)RT * FF * 2 <= WS_MIX, "ACT overlay");

constexpr int MISC_OFF = 147456, LDS_BYTES = MISC_OFF + 256;

__device__ __forceinline__ int rfl(int v) { return __builtin_amdgcn_readfirstlane(v); }
__device__ __forceinline__ unsigned pkbf(float lo, float hi) { f32x2 v = {lo, hi}; bf16x2_t b = __builtin_convertvector(v, bf16x2_t); return __builtin_bit_cast(unsigned, b); }
__device__ __forceinline__ float bflo(unsigned u) { return __uint_as_float(u << 16); }
__device__ __forceinline__ float bfhi(unsigned u) { return __uint_as_float(u & 0xffff0000u); }
__device__ __forceinline__ float wave_sum(float v) {
#pragma unroll
    for (int o = 1; o < 64; o <<= 1) v += __shfl_xor(v, o);
    return v;
}
__device__ __forceinline__ float xhalf_max(float m) { auto rr = __builtin_amdgcn_permlane32_swap(__float_as_uint(m), __float_as_uint(m), false, false); return fmaxf(__uint_as_float(rr[0]), __uint_as_float(rr[1])); }
__device__ __forceinline__ float xhalf_sum(float m) { auto rr = __builtin_amdgcn_permlane32_swap(__float_as_uint(m), __float_as_uint(m), false, false); return __uint_as_float(rr[0]) + __uint_as_float(rr[1]); }
#define LDS_WAIT() asm volatile("s_waitcnt lgkmcnt(0)" ::: "memory")
__device__ __forceinline__ float max3f(float a, float b, float c) { float r; asm("v_max3_f32 %0, %1, %2, %3" : "=v"(r) : "v"(a), "v"(b), "v"(c)); return r; }

struct Params { const float* in[27]; float* out; unsigned char* ws; int ph_lo, ph_hi; };
typedef const __attribute__((address_space(4))) Params* PK;
__device__ __forceinline__ PK pk_get() { PK p = (PK)__builtin_amdgcn_kernarg_segment_ptr(); asm volatile("" : "+s"(p)); return p; }
enum { I_X = 0, I_C, I_CTX, I_CCTX, I_WADA, I_BADA, I_NORMG, I_WIN, I_DLAM, I_SUBG, I_HYSW, I_HW1, I_HB1, I_HW2, I_HB2, I_HW3, I_HFREQ, I_HBIAS,
       I_POOLW, I_PSCALE, I_WAO, I_WHO, I_WPO, I_WOUT, I_WUP, I_FFCW, I_WDN };
namespace pg8 {
#define PG8_LAS __attribute__((address_space(3)))
typedef unsigned short bf16_t;
typedef short bf16x8 __attribute__((ext_vector_type(8)));
typedef float f32x4 __attribute__((ext_vector_type(4)));
typedef unsigned u32x4 __attribute__((ext_vector_type(4)));
constexpr int BM = 256, BK = 64, HALF = 128, HTB = HALF * BK * 2  , STAGE_BYTES = 8 * HTB, NXCD = 8, WGM = 8;

__host__ __device__ __forceinline__ int lds_byte(int r, int c) { const int st = (r >> 4) * 2 + (c >> 5), rr = r & 15, cc = c & 31, ob = rr * 64 + cc * 2; return st * 1024 + (ob ^ (((ob >> 9) & 1) << 5)); }
__host__ __device__ __forceinline__ void stage_rc(int b, int& R, int& C) { const int st = b / 1024, sb = b % 1024, swz = sb ^ (((sb >> 9) & 1) << 5); R = (st >> 1) * 16 + swz / 64; C = (st & 1) * 32 + (swz % 64) / 2; }
__host__ __device__ __forceinline__ int perm32(int rho) { const int n = rho >> 4, i = rho & 15; return 8 * (i >> 2) + 4 * n + (i & 3); }

struct Unit { int pm, pn, ko, ks, kt; };
struct Gemm { const bf16_t* A; const bf16_t* Bt; int M, N, K, lda, ldb; };

struct StaticOrder {
    int nM, nN, nwg, G, c;
    __host__ __device__ void init(int M, int N, int G_, int c_) { nM = M / BM; nN = N / BM; nwg = nM * nN; G = G_; c = c_; }
    __host__ __device__ bool next(int i, Unit& u) const {
        const long L = (long)i * G + c; if (L >= nwg) return false;
        int wgid = (int)L; { const int q = nwg / NXCD, r = nwg % NXCD, xcd = wgid % NXCD, off = wgid / NXCD; wgid = (xcd < r ? xcd * (q + 1) : r * (q + 1) + (xcd - r) * q) + off; }
        const int nig = WGM * nN, gid = wgid / nig, fm = gid * WGM, gsz = (nM - fm) < WGM ? (nM - fm) : WGM;
        u.pm = fm + ((wgid % nig) % gsz); u.pn = (wgid % nig) / gsz; u.ko = 0; u.ks = 0; u.kt = 0; return true;
    }
    __device__ __forceinline__ void a_ready(const Unit&) const {}
    __device__ __forceinline__ void done(const Unit&) const {}
};
__device__ __forceinline__ unsigned cvt_pk_bf16(float lo, float hi) { unsigned r; asm volatile("v_cvt_pk_bf16_f32 %0, %1, %2" : "=v"(r) : "v"(lo), "v"(hi)); return r; }
template <class Epi, class Sched, bool ALIGN_EPI = false, bool SP2 = false>
__device__ __forceinline__ void gemm_phase(PG8_LAS unsigned char* lds, const Gemm g, const Sched& S, const Epi& E) {
    int tid_ = threadIdx.x; asm volatile("" : "+v"(tid_));
    const int tid = tid_, wid = __builtin_amdgcn_readfirstlane(tid >> 6), lane = tid & 63, wr = wid >> 2, wc = wid & 3, fr = lane & 15, fq = lane >> 4;
    const int ntdef = g.K / BK;
    unsigned voffA[2], voffB[2];
#pragma unroll
    for (int i = 0; i < 2; ++i) { int R, C; stage_rc(tid * 16 + i * 8192, R, C); const int Rb = Epi::PERM ? ((R & ~31) + perm32(R & 31)) : R;
        voffA[i] = (unsigned)(R * g.lda + C) * 2u; voffB[i] = (unsigned)(Rb * g.ldb + C) * 2u; }
    const size_t kstep = (size_t)(BK * 2);
    const size_t hstepA = (size_t)HALF * g.lda * 2, hstepB = (size_t)HALF * g.ldb * 2;
    const size_t tstepA = 2 * hstepA, tstepB = 2 * hstepB;
    const unsigned ldsw = (unsigned)wid * 1024u;
    const int aoff = lds_byte(wr * 64 + fr, fq * 8), boff = lds_byte(wc * 32 + fr, fq * 8);
#define PG8_SA(b, h) (((b) * 2 + (h)) * HTB)
#define PG8_SB(b, h) ((4 + (b) * 2 + (h)) * HTB)
#define PG8_STAGE(bufoff, gbase, voff) do { _Pragma("unroll") for (int _i = 0; _i < 2; ++_i) \
        __builtin_amdgcn_global_load_lds((const unsigned*)((const char*)(gbase) + (voff)[_i]), (PG8_LAS unsigned*)(lds + (bufoff) + ldsw + _i * 8192), 16, 0, 0); } while (0)
#define PG8_LDA(dst, b, h) do { _Pragma("unroll") for (int m = 0; m < 4; ++m) _Pragma("unroll") for (int k = 0; k < 2; ++k) dst[m][k] = *(const PG8_LAS bf16x8*)(lds + PG8_SA(b, h) + aoff + m * 2048 + k * 1024); } while (0)
#define PG8_LDB(dst, b, h) do { _Pragma("unroll") for (int n = 0; n < 2; ++n) _Pragma("unroll") for (int k = 0; k < 2; ++k) dst[n][k] = *(const PG8_LAS bf16x8*)(lds + PG8_SB(b, h) + boff + n * 2048 + k * 1024); } while (0)
#define PG8_MMA(ai, bj, At, Bt) do { __builtin_amdgcn_s_setprio(1); _Pragma("unroll") for (int m = 0; m < 4; ++m) _Pragma("unroll") for (int n = 0; n < 2; ++n) _Pragma("unroll") for (int k = 0; k < 2; ++k) \
        acc[ai][bj][m][n] = __builtin_amdgcn_mfma_f32_16x16x32_bf16(Bt[n][k], At[m][k], acc[ai][bj][m][n], 0, 0, 0); __builtin_amdgcn_s_setprio(0); } while (0)
#define PG8_WAIT_V(n) asm volatile("s_waitcnt vmcnt(" #n ")" ::: "memory")
#define PG8_WAIT_L(n) asm volatile("s_waitcnt lgkmcnt(" #n ")" ::: "memory")
#define PG8_BAR __builtin_amdgcn_s_barrier()
#define PG8_SCHED __builtin_amdgcn_sched_barrier(0)
    Unit cur, nxt; int ui = 0;
    if (!S.next(0, cur)) return;
    f32x4 acc[2][2][4][2];
#pragma unroll
    for (int a = 0; a < 2; ++a)
#pragma unroll
        for (int b = 0; b < 2; ++b)
#pragma unroll
            for (int m = 0; m < 4; ++m)
#pragma unroll
                for (int n = 0; n < 2; ++n) acc[a][b][m][n] = (f32x4){0.f, 0.f, 0.f, 0.f};
    bf16x8 At[4][2], B0[2][2], B1[2][2];
    const char* cA = (const char*)g.A + (size_t)cur.pm * tstepA + (size_t)cur.ko * 2; const char* cB = (const char*)g.Bt + (size_t)cur.pn * tstepB + (size_t)cur.ko * 2;
    S.a_ready(cur);
    if constexpr (SP2) {
        PG8_STAGE(PG8_SB(0, 0), cB, voffB); PG8_STAGE(PG8_SB(0, 1), cB + hstepB, voffB); PG8_STAGE(PG8_SA(0, 0), cA, voffA); PG8_STAGE(PG8_SA(0, 1), cA + hstepA, voffA);
        if (wr == 1) PG8_BAR;
        PG8_WAIT_V(2); PG8_BAR;
        PG8_STAGE(PG8_SB(1, 0), cB + kstep, voffB); PG8_STAGE(PG8_SA(1, 0), cA + kstep, voffA); PG8_STAGE(PG8_SB(1, 1), cB + hstepB + kstep, voffB);
        PG8_WAIT_V(6); PG8_BAR;
    } else {
        PG8_STAGE(PG8_SB(0, 0), cB, voffB); PG8_STAGE(PG8_SA(0, 0), cA, voffA); PG8_STAGE(PG8_SB(0, 1), cB + hstepB, voffB); PG8_STAGE(PG8_SA(0, 1), cA + hstepA, voffA);
        if (wr == 1) PG8_BAR;
        PG8_WAIT_V(4); PG8_BAR;
        PG8_STAGE(PG8_SB(1, 0), cB + kstep, voffB); PG8_STAGE(PG8_SA(1, 0), cA + kstep, voffA); PG8_STAGE(PG8_SB(1, 1), cB + hstepB + kstep, voffB);
        PG8_WAIT_V(6); PG8_BAR;
    }
    for (;;) {
        const bool has_next = S.next(ui + 1, nxt);
        const char* nA = has_next ? (const char*)g.A + (size_t)nxt.pm * tstepA + (size_t)nxt.ko * 2 : cA; const char* nB = has_next ? (const char*)g.Bt + (size_t)nxt.pn * tstepB + (size_t)nxt.ko * 2 : cB;
        const int nt = cur.kt ? cur.kt : ntdef;
        for (int t = 0; t < nt; t += 2) {
            const bool last = (t == nt - 2);
            const char* a1 = cA + (size_t)(t + 1) * kstep;
            const char* a2 = last ? nA : cA + (size_t)(t + 2) * kstep; const char* b2 = last ? nB : cB + (size_t)(t + 2) * kstep;
            const char* a3 = a2 + kstep; const char* b3 = b2 + kstep;
            if (last && has_next) S.a_ready(nxt);
            if constexpr (SP2) {
            PG8_LDB(B0, 0, 0); PG8_LDB(B1, 0, 1); PG8_SCHED; PG8_LDA(At, 0, 0); PG8_STAGE(PG8_SA(1, 1), a1 + hstepA, voffA);
            PG8_WAIT_V(8); PG8_WAIT_L(0); PG8_BAR; PG8_MMA(0, 0, At, B0); PG8_MMA(0, 1, At, B1); PG8_BAR; PG8_SCHED;
            PG8_LDA(At, 0, 1); PG8_STAGE(PG8_SB(0, 0), b2, voffB); PG8_STAGE(PG8_SB(0, 1), b2 + hstepB, voffB); PG8_STAGE(PG8_SA(0, 0), a2, voffA);
            PG8_WAIT_V(8); PG8_WAIT_L(0); PG8_BAR; PG8_MMA(1, 0, At, B0); PG8_MMA(1, 1, At, B1); PG8_BAR; PG8_SCHED;
            PG8_LDB(B0, 1, 0); PG8_LDB(B1, 1, 1); PG8_SCHED; PG8_LDA(At, 1, 0); PG8_STAGE(PG8_SA(0, 1), a2 + hstepA, voffA);
            PG8_WAIT_V(8); PG8_WAIT_L(0); PG8_BAR; PG8_MMA(0, 0, At, B0); PG8_MMA(0, 1, At, B1); PG8_BAR; PG8_SCHED;
            PG8_LDA(At, 1, 1); PG8_STAGE(PG8_SB(1, 0), b3, voffB); PG8_STAGE(PG8_SB(1, 1), b3 + hstepB, voffB); PG8_STAGE(PG8_SA(1, 0), a3, voffA);
            PG8_WAIT_V(8); PG8_WAIT_L(0); PG8_BAR; PG8_MMA(1, 0, At, B0); PG8_MMA(1, 1, At, B1); PG8_BAR; PG8_SCHED;
            } else {
            PG8_LDB(B0, 0, 0); PG8_SCHED; PG8_LDA(At, 0, 0); PG8_STAGE(PG8_SA(1, 1), a1 + hstepA, voffA);
            PG8_WAIT_L(8); PG8_BAR; PG8_WAIT_L(0); PG8_MMA(0, 0, At, B0); PG8_BAR; PG8_SCHED;
            PG8_LDB(B1, 0, 1); PG8_STAGE(PG8_SB(0, 0), b2, voffB);
            PG8_BAR; PG8_WAIT_L(0); PG8_MMA(0, 1, At, B1); PG8_BAR;
            PG8_LDA(At, 0, 1); PG8_STAGE(PG8_SA(0, 0), a2, voffA);
            PG8_BAR; PG8_WAIT_L(0); PG8_MMA(1, 0, At, B0); PG8_BAR; PG8_SCHED;
            PG8_STAGE(PG8_SB(0, 1), b2 + hstepB, voffB);
            PG8_WAIT_V(6); PG8_BAR; PG8_MMA(1, 1, At, B1); PG8_BAR;
            PG8_LDB(B0, 1, 0); PG8_SCHED; PG8_LDA(At, 1, 0); PG8_STAGE(PG8_SA(0, 1), a2 + hstepA, voffA);
            PG8_WAIT_L(8); PG8_BAR; PG8_WAIT_L(0); PG8_MMA(0, 0, At, B0); PG8_BAR; PG8_SCHED;
            PG8_LDB(B1, 1, 1); PG8_STAGE(PG8_SB(1, 0), b3, voffB);
            PG8_BAR; PG8_WAIT_L(0); PG8_MMA(0, 1, At, B1); PG8_BAR;
            PG8_LDA(At, 1, 1); PG8_STAGE(PG8_SA(1, 0), a3, voffA);
            PG8_BAR; PG8_WAIT_L(0); PG8_MMA(1, 0, At, B0); PG8_BAR; PG8_SCHED;
            PG8_STAGE(PG8_SB(1, 1), b3 + hstepB, voffB);
            PG8_WAIT_V(6); PG8_BAR; PG8_MMA(1, 1, At, B1); PG8_BAR;
            }
        }
        if constexpr (ALIGN_EPI) { if (wr == 0) PG8_BAR; }
        if constexpr (!Epi::AFTER_DRAIN) { E(acc, cur, wr, wc, fr, fq); S.done(cur); }
        if (!has_next) break;
        if (!E.keep(cur)) {
#pragma unroll
        for (int a = 0; a < 2; ++a)
#pragma unroll
            for (int b = 0; b < 2; ++b)
#pragma unroll
                for (int m = 0; m < 4; ++m)
#pragma unroll
                    for (int n = 0; n < 2; ++n) acc[a][b][m][n] = (f32x4){0.f, 0.f, 0.f, 0.f};
        }
        cur = nxt; cA = nA; cB = nB; ++ui;
        if constexpr (ALIGN_EPI) { if (wr == 1) PG8_BAR; }
    }
    PG8_WAIT_V(0);
    if constexpr (!ALIGN_EPI) { if (wr == 0) PG8_BAR; }
    PG8_BAR;
    if constexpr (Epi::AFTER_DRAIN) { E.fused(acc, cur, wr, wc, fr, fq, lds, wid, lane); S.done(cur); }
#undef PG8_SA
#undef PG8_SB
#undef PG8_STAGE
#undef PG8_LDA
#undef PG8_LDB
#undef PG8_MMA
#undef PG8_WAIT_V
#undef PG8_WAIT_L
#undef PG8_BAR
#undef PG8_SCHED
}
}
#define XB_TMO      128
#define XB_XCNT(j)  (256  + 64 * (j))
#define XB_XSUB(j)  (1280 + 64 * (j))
#define XB_XGEN(j)  (2304 + 64 * (j))
#define XB_TOP      3328
#define XB_TOPGEN   3392
#define XCD_BAR_WORDS 3456
#define XB_SPIN_CAP (1u << 18)

__device__ __forceinline__ unsigned xb_ld(unsigned* p)              { return __hip_atomic_load(p, __ATOMIC_RELAXED, __HIP_MEMORY_SCOPE_AGENT); }
__device__ __forceinline__ unsigned xb_add(unsigned* p, unsigned v) { return __hip_atomic_fetch_add(p, v, __ATOMIC_RELAXED, __HIP_MEMORY_SCOPE_AGENT); }
__device__ __forceinline__ unsigned xb_xcc_id() { return (unsigned)__builtin_amdgcn_s_getreg((3 << 11) | 20) & 0xFu; }
#define XB_SPIN(cond, bar) do { unsigned _sp = 0; while (cond) { __builtin_amdgcn_s_sleep(1); \
    if ((++_sp & 255u) == 0u) { if (xb_ld(&(bar)[XB_TMO])) break; if (_sp > XB_SPIN_CAP) { atomicAdd(&(bar)[XB_TMO], 1u); break; } } } } while (0)

struct XcdBarrier {
    unsigned* bar; unsigned x;
    volatile LAS unsigned* st;
};

__device__ __forceinline__ XcdBarrier xcd_barrier_post(unsigned* bar, volatile LAS unsigned* st) {
    XcdBarrier b; b.bar = bar; b.x = xb_xcc_id(); b.st = st;
    if (threadIdx.x == 0) (void)xb_add(&bar[XB_XCNT(b.x)], 1u);
    return b;
}
__device__ __forceinline__ void xcd_barrier_complete(unsigned* bar, unsigned x, unsigned& nloc, unsigned& nx) {
    const unsigned G = gridDim.x * gridDim.y * gridDim.z;
    unsigned sum, cnt, mine, sp = 0u;
    for (;;) {
        sum = 0u; cnt = 0u; mine = 0u;
#pragma unroll
        for (unsigned j = 0; j < 16; ++j) { const unsigned c = xb_ld(&bar[XB_XCNT(j)]); sum += c; cnt += (c > 0u) ? 1u : 0u; mine = (j == x) ? c : mine; }
        if (sum == G) break;
        __builtin_amdgcn_s_sleep(1);
        if ((++sp & 255u) == 0u) { if (xb_ld(&bar[XB_TMO])) break; if (sp > XB_SPIN_CAP) { atomicAdd(&bar[XB_TMO], 1u); break; } }
    }
    nloc = mine > 0u ? mine : 1u; nx = cnt > 0u ? cnt : 1u;
}

__device__ __forceinline__ void xcd_barrier(const XcdBarrier& b) {
    asm volatile("s_waitcnt vmcnt(0)" ::: "memory");
    __syncthreads();
    if (threadIdx.x == 0) {
        unsigned* bar = b.bar;
        __builtin_amdgcn_s_waitcnt(0);
        unsigned nloc = b.st[0], nx = b.st[1];
        if (nloc == 0u) { xcd_barrier_complete(bar, b.x, nloc, nx); b.st[0] = nloc; b.st[1] = nx; }
        const unsigned old = xb_add(&bar[XB_XSUB(b.x)], 1u);
        const unsigned gen = old / nloc;
        if (old + 1u == (gen + 1u) * nloc) {
            __builtin_amdgcn_fence(__ATOMIC_RELEASE, "agent");
            asm volatile("s_waitcnt vmcnt(0)" ::: "memory");
            const unsigned og = xb_add(&bar[XB_TOP], 1u);
            const unsigned tg = og / nx;
            if (og + 1u == (tg + 1u) * nx) xb_add(&bar[XB_TOPGEN], 1u);
            else XB_SPIN(xb_ld(&bar[XB_TOPGEN]) == tg, bar);
            __builtin_amdgcn_fence(__ATOMIC_ACQUIRE, "agent");
            xb_add(&bar[XB_XGEN(b.x)], 1u);
            asm volatile("s_waitcnt vmcnt(0)" ::: "memory");
        } else {
            XB_SPIN(xb_ld(&bar[XB_XGEN(b.x)]) == gen, bar);
            __builtin_amdgcn_fence(__ATOMIC_ACQUIRE, "agent");
            asm volatile("s_waitcnt vmcnt(0)" ::: "memory");
        }
    }
    __syncthreads();
}
struct OrderX {
    pg8::StaticOrder base; int extra;
    __device__ __forceinline__ bool next(int i, pg8::Unit& u) const {
        long L = (long)i * base.G + base.c;
        if (L < base.nwg) return base.next(i, u);
        L -= base.nwg; if (L >= extra) return false;
        u.pm = 32 + (int)(L >> 3); u.pn = 4 + (int)(L & 7); u.ko = 0; u.ks = 0; u.kt = 0; return true;
    }
    __device__ __forceinline__ void a_ready(const pg8::Unit&) const {}
    __device__ __forceinline__ void done(const pg8::Unit&) const {}
};

struct EpiPlain {
    static constexpr bool PERM = true, AFTER_DRAIN = false; __device__ __forceinline__ bool keep(const pg8::Unit&) const { return false; }
    bf16* O; int ldc;
    __device__ __forceinline__ void operator()(const f32x4 (&acc)[2][2][4][2], const pg8::Unit& u, int wr, int wc, int fr, int fq) const {
        const int row0 = u.pm * 256 + wr * 64 + fr, col0 = u.pn * 256 + wc * 32 + 8 * fq;
#pragma unroll
        for (int ai = 0; ai < 2; ++ai)
#pragma unroll
            for (int m = 0; m < 4; ++m) { bf16* rowp = O + (size_t)(row0 + ai * 128 + m * 16) * ldc + col0;
#pragma unroll
                for (int bj = 0; bj < 2; ++bj) { const f32x4 v0 = acc[ai][bj][m][0], v1 = acc[ai][bj][m][1];
                    u32x4 w; w.x = pkbf(v0[0], v0[1]); w.y = pkbf(v0[2], v0[3]); w.z = pkbf(v1[0], v1[1]); w.w = pkbf(v1[2], v1[3]);
                    *(u32x4*)(rowp + bj * 128) = w; } }
    }
};

struct EpiG1 {
    static constexpr bool PERM = true, AFTER_DRAIN = false; __device__ __forceinline__ bool keep(const pg8::Unit&) const { return false; }
    bf16* QKV; bf16* HYT; bf16* PL; bf16* GT; const float* ropeC; const float* ropeS;
    __device__ __forceinline__ void operator()(const f32x4 (&acc)[2][2][4][2], const pg8::Unit& u, int wr, int wc, int fr, int fq) const {
        const int pn = u.pn, pm = u.pm;
        const int row0 = pm * 256 + wr * 64 + fr;
        if (pn < 12) {
            const bool rope = (pn < 8) && (pm < 32);
            const float sc = (pn < 4) ? QSCALE : 1.f;
            const int col0 = pn * 256 + wc * 32 + 8 * fq;
#pragma unroll
            for (int ai = 0; ai < 2; ++ai) {
                f32x4 csv[4], snv[4];
#pragma unroll
                for (int m = 0; m < 4; ++m) { csv[m] = (f32x4){1.f, 1.f, 1.f, 1.f}; snv[m] = (f32x4){0.f, 0.f, 0.f, 0.f};
                    if (rope) { const int t = (row0 + ai * 128 + m * 16) & (SEQ - 1); const int pos = (wc & 1) ? (t & 63) : (t >> 6);
                        csv[m] = *(const f32x4*)(ropeC + pos * 16 + 4 * fq); snv[m] = *(const f32x4*)(ropeS + pos * 16 + 4 * fq); } }
                __builtin_amdgcn_sched_barrier(0);
#pragma unroll
                for (int m = 0; m < 4; ++m) {
                    const int row = row0 + ai * 128 + m * 16;
                    const f32x4 cs = csv[m], sn = snv[m];
                    bf16* rowp = QKV + (size_t)row * NQKV + col0;
#pragma unroll
                    for (int bj = 0; bj < 2; ++bj) { const f32x4 v0 = acc[ai][bj][m][0], v1 = acc[ai][bj][m][1];
                        float o0 = v0[0] * cs[0] - v0[1] * sn[0], o1 = v0[1] * cs[0] + v0[0] * sn[0];
                        float o2 = v0[2] * cs[1] - v0[3] * sn[1], o3 = v0[3] * cs[1] + v0[2] * sn[1];
                        float o4 = v1[0] * cs[2] - v1[1] * sn[2], o5 = v1[1] * cs[2] + v1[0] * sn[2];
                        float o6 = v1[2] * cs[3] - v1[3] * sn[3], o7 = v1[3] * cs[3] + v1[2] * sn[3];
                        u32x4 w; w.x = pkbf(o0 * sc, o1 * sc); w.y = pkbf(o2 * sc, o3 * sc); w.z = pkbf(o4 * sc, o5 * sc); w.w = pkbf(o6 * sc, o7 * sc);
                        *(u32x4*)(rowp + bj * 128) = w; }
                }
            }
        } else if (pn < 18) {
            const int ch0 = (pn - 12) * 256 + wc * 32 + 8 * fq;
            const int odd = fr & 1;
#pragma unroll
            for (int ai = 0; ai < 2; ++ai)
#pragma unroll
                for (int m = 0; m < 4; ++m) {
                    const int row = row0 + ai * 128 + m * 16;
#pragma unroll
                    for (int bj = 0; bj < 2; ++bj) { const f32x4 v0 = acc[ai][bj][m][0], v1 = acc[ai][bj][m][1];
                        unsigned pk[4] = {pkbf(v0[0], v0[1]), pkbf(v0[2], v0[3]), pkbf(v1[0], v1[1]), pkbf(v1[2], v1[3])};
#pragma unroll
                        for (int j = 0; j < 4; ++j) { const unsigned nb = (unsigned)__shfl_xor((int)pk[j], 1);
                            const unsigned o = odd ? ((nb >> 16) | (pk[j] & 0xffff0000u)) : ((pk[j] & 0xffffu) | (nb << 16));
                            const int ch = ch0 + bj * 128 + 2 * j + odd;
                            *(unsigned*)(HYT + (size_t)ch * RT + (row - odd)) = o; }
                    }
                }
        } else if (pn < 20) {
            const int col0 = (pn - 18) * 256 + wc * 32 + 8 * fq;
#pragma unroll
            for (int ai = 0; ai < 2; ++ai)
#pragma unroll
                for (int m = 0; m < 4; ++m) { bf16* rowp = PL + (size_t)(row0 + ai * 128 + m * 16) * PWD + col0;
#pragma unroll
                    for (int bj = 0; bj < 2; ++bj) { const f32x4 v0 = acc[ai][bj][m][0], v1 = acc[ai][bj][m][1];
                        u32x4 w; w.x = pkbf(v0[0], v0[1]); w.y = pkbf(v0[2], v0[3]); w.z = pkbf(v1[0], v1[1]); w.w = pkbf(v1[2], v1[3]);
                        *(u32x4*)(rowp + bj * 128) = w; } }
        } else {
            const int col0 = (pn - 20) * 256 + wc * 32 + 8 * fq;
#pragma unroll
            for (int ai = 0; ai < 2; ++ai)
#pragma unroll
                for (int m = 0; m < 4; ++m) { bf16* rowp = GT + (size_t)(row0 + ai * 128 + m * 16) * NGT + col0;
#pragma unroll
                    for (int bj = 0; bj < 2; ++bj) { const f32x4 v0 = acc[ai][bj][m][0], v1 = acc[ai][bj][m][1];
                        float s[8];
#pragma unroll
                        for (int i = 0; i < 4; ++i) { s[i] = __builtin_amdgcn_rcpf(1.f + __builtin_amdgcn_exp2f(-1.4426950408889634f * v0[i])); s[4 + i] = __builtin_amdgcn_rcpf(1.f + __builtin_amdgcn_exp2f(-1.4426950408889634f * v1[i])); }
                        u32x4 w; w.x = pkbf(s[0], s[1]); w.y = pkbf(s[2], s[3]); w.z = pkbf(s[4], s[5]); w.w = pkbf(s[6], s[7]);
                        *(u32x4*)(rowp + bj * 128) = w; } }
        }
    }
};

struct EpiG2 {
    static constexpr bool PERM = true, AFTER_DRAIN = false;
    const bf16* GT; bf16* MERGED;
    __device__ __forceinline__ bool keep(const pg8::Unit& u) const { return u.ks < 3; }
    __device__ __forceinline__ void operator()(f32x4 (&acc)[2][2][4][2], const pg8::Unit& u, int wr, int wc, int fr, int fq) const {
        if (u.ks == 0) return;
        const int seg = u.ks - 1;
        int lane_; asm volatile("v_mbcnt_lo_u32_b32 %0, -1, 0\n\tv_mbcnt_hi_u32_b32 %0, -1, %0" : "=v"(lane_));
        const int fr_ = lane_ & 15, fq_ = lane_ >> 4; (void)fr; (void)fq;
        const int row0 = u.pm * 256 + wr * 64 + fr_, col0 = u.pn * 256 + wc * 32 + 8 * fq_;
        const float eps = 1e-30f;
        if (seg < 2) {
#pragma unroll
            for (int h = 0; h < 4; ++h) { const int ai = h >> 1, bj = h & 1; const int col = col0 + bj * 128;
                u32x4 gn[4], gd[4];
#pragma unroll
                for (int m = 0; m < 4; ++m) { const size_t row = (size_t)(row0 + ai * 128 + m * 16);
                    gn[m] = *(const u32x4*)(GT + row * NGT + seg * DM + col); gd[m] = *(const u32x4*)(GT + row * NGT + (seg + 1) * DM + col); }
                __builtin_amdgcn_sched_barrier(0);
#pragma unroll
                for (int m = 0; m < 4; ++m) {
                    f32x4 f0 = {fmaxf(bflo(gn[m].x), eps) * __builtin_amdgcn_rcpf(fmaxf(bflo(gd[m].x), eps)), fmaxf(bfhi(gn[m].x), eps) * __builtin_amdgcn_rcpf(fmaxf(bfhi(gd[m].x), eps)),
                                fmaxf(bflo(gn[m].y), eps) * __builtin_amdgcn_rcpf(fmaxf(bflo(gd[m].y), eps)), fmaxf(bfhi(gn[m].y), eps) * __builtin_amdgcn_rcpf(fmaxf(bfhi(gd[m].y), eps))};
                    f32x4 f1 = {fmaxf(bflo(gn[m].z), eps) * __builtin_amdgcn_rcpf(fmaxf(bflo(gd[m].z), eps)), fmaxf(bfhi(gn[m].z), eps) * __builtin_amdgcn_rcpf(fmaxf(bfhi(gd[m].z), eps)),
                                fmaxf(bflo(gn[m].w), eps) * __builtin_amdgcn_rcpf(fmaxf(bflo(gd[m].w), eps)), fmaxf(bfhi(gn[m].w), eps) * __builtin_amdgcn_rcpf(fmaxf(bfhi(gd[m].w), eps))};
                    acc[ai][bj][m][0] *= f0; acc[ai][bj][m][1] *= f1; }
                __builtin_amdgcn_sched_barrier(0);
            }
        } else {
#pragma unroll
            for (int h = 0; h < 4; ++h) { const int ai = h >> 1, bj = h & 1; const int col = col0 + bj * 128;
                u32x4 gn[4];
#pragma unroll
                for (int m = 0; m < 4; ++m) { const size_t row = (size_t)(row0 + ai * 128 + m * 16); gn[m] = *(const u32x4*)(GT + row * NGT + 2 * DM + col); }
                __builtin_amdgcn_sched_barrier(0);
#pragma unroll
                for (int m = 0; m < 4; ++m) { const size_t row = (size_t)(row0 + ai * 128 + m * 16);
                    const f32x4 v0 = acc[ai][bj][m][0], v1 = acc[ai][bj][m][1];
                    f32x4 a0 = {v0[0] * fmaxf(bflo(gn[m].x), eps), v0[1] * fmaxf(bfhi(gn[m].x), eps), v0[2] * fmaxf(bflo(gn[m].y), eps), v0[3] * fmaxf(bfhi(gn[m].y), eps)};
                    f32x4 a1 = {v1[0] * fmaxf(bflo(gn[m].z), eps), v1[1] * fmaxf(bfhi(gn[m].z), eps), v1[2] * fmaxf(bflo(gn[m].w), eps), v1[3] * fmaxf(bfhi(gn[m].w), eps)};
                    u32x4 w; w.x = pkbf(a0[0], a0[1]); w.y = pkbf(a0[2], a0[3]); w.z = pkbf(a1[0], a1[1]); w.w = pkbf(a1[2], a1[3]);
                    *(u32x4*)(MERGED + row * DM + col) = w; }
                __builtin_amdgcn_sched_barrier(0);
            }
        }
    }
};
struct OrderG2 {
    pg8::StaticOrder base; bool ctx2 = false; int pm0 = 0, pn0 = 0, pm1 = -1;
    __device__ __forceinline__ void init2() { pg8::Unit f; base.next(0, f); pm0 = f.pm; pn0 = f.pn; pm1 = (f.pm & 7) ? -1 : 32 + (f.pm >> 3); }
    __device__ __forceinline__ bool next(int i, pg8::Unit& u) const {
        const int t = i >> 2;
        if (!ctx2) { if (!base.next(t, u)) return false; }
        else { if (t > 1 || (t == 1 && pm1 < 0)) return false; u.pm = t ? pm1 : pm0; u.pn = pn0; }
        u.ks = i & 3; u.ko = 512 * (i & 3); u.kt = 0; return true; }
    __device__ __forceinline__ void a_ready(const pg8::Unit&) const {}
    __device__ __forceinline__ void done(const pg8::Unit&) const {}
};

struct SplitOrder {
    int nsub, S, kslice, G, c;
    __device__ __forceinline__ bool next(int i, pg8::Unit& u) const {
        const int j = i * G + c; if (j >= nsub) return false;
        const int tile = j / S, ks = j - tile * S; u.pm = 32 + (tile >> 3); u.pn = tile & 7; u.ko = ks * kslice; u.ks = ks; u.kt = kslice >> 6; return true;
    }
    __device__ __forceinline__ void a_ready(const pg8::Unit&) const {}
    __device__ __forceinline__ void done(const pg8::Unit&) const {}
};
struct EpiSlab {
    static constexpr bool PERM = true, AFTER_DRAIN = false; __device__ __forceinline__ bool keep(const pg8::Unit&) const { return false; }
    float* SLAB;
    __device__ __forceinline__ void operator()(const f32x4 (&acc)[2][2][4][2], const pg8::Unit& u, int wr, int wc, int fr, int fq) const {
        const int row0 = (u.pm - 32) * 256 + wr * 64 + fr, col0 = u.pn * 256 + wc * 32 + 8 * fq;
        bf16* base = (bf16*)SLAB + (size_t)u.ks * RC * DM;
#pragma unroll
        for (int ai = 0; ai < 2; ++ai)
#pragma unroll
            for (int m = 0; m < 4; ++m) { bf16* rowp = base + (size_t)(row0 + ai * 128 + m * 16) * DM + col0;
#pragma unroll
                for (int bj = 0; bj < 2; ++bj) { const f32x4 v0 = acc[ai][bj][m][0], v1 = acc[ai][bj][m][1];
                    u32x4 w; w.x = pkbf(v0[0], v0[1]); w.y = pkbf(v0[2], v0[3]); w.z = pkbf(v1[0], v1[1]); w.w = pkbf(v1[2], v1[3]);
                    *(u32x4*)(rowp + bj * 128) = w; } }
    }
};

template <int CTRL> __device__ __forceinline__ float dppf(float x) { return __builtin_bit_cast(float, __builtin_amdgcn_update_dpp(0, __builtin_bit_cast(int, x), CTRL, 0xf, 0xf, true)); }
__device__ __forceinline__ float gelu_tanh_f(float a) { const float u = 0.7978845608028654f * (a + 0.044715f * a * a * a); return a * __builtin_amdgcn_rcpf(1.f + __builtin_amdgcn_exp2f(-2.f * 1.4426950408889634f * u)); }
struct OrderLatCtx {
    pg8::StaticOrder base; SplitOrder sp; int nlat; bool ctx;
    __device__ __forceinline__ void init(int M, int N, int G, int c) { base.init(M, N, G, c); nlat = c < base.nwg ? (base.nwg - c + G - 1) / G : 0; }
    __device__ __forceinline__ bool next(int i, pg8::Unit& u) const { if (i < nlat) return base.next(i, u); return ctx && sp.next(i - nlat, u); }
    __device__ __forceinline__ void a_ready(const pg8::Unit&) const {}
    __device__ __forceinline__ void done(const pg8::Unit&) const {}
};
struct EpiPlainSlab {
    static constexpr bool PERM = true, AFTER_DRAIN = false; __device__ __forceinline__ bool keep(const pg8::Unit&) const { return false; }
    EpiPlain a; EpiSlab b;
    __device__ __forceinline__ void operator()(const f32x4 (&acc)[2][2][4][2], const pg8::Unit& u, int wr, int wc, int fr, int fq) const { if (u.pm >= 32) b(acc, u, wr, wc, fr, fq); else a(acc, u, wr, wc, fr, fq); }
};
struct EpiG4F {
    static constexpr bool PERM = true, AFTER_DRAIN = false; __device__ __forceinline__ bool keep(const pg8::Unit&) const { return false; }
    bf16* ACT; bf16* EG; bf16* EV; const float* cw;
    __device__ __forceinline__ void operator()(const f32x4 (&acc)[2][2][4][2], const pg8::Unit& u, int wr, int wc, int fr, int fq) const {
        const int ch0 = u.pn * 128 + wc * 32 + 8 * fq;
        float w0[8], w1[8], w2[8];
#pragma unroll
        for (int i = 0; i < 8; i += 4) { *(f32x4*)(w0 + i) = *(const f32x4*)(cw + ch0 + i); *(f32x4*)(w1 + i) = *(const f32x4*)(cw + FF + ch0 + i); *(f32x4*)(w2 + i) = *(const f32x4*)(cw + 2 * FF + ch0 + i); }
#pragma unroll
        for (int ai = 0; ai < 2; ++ai) {
            const int brow = u.pm * 256 + ai * 128 + wr * 64, blk = brow >> 6;
#pragma unroll
            for (int m = 0; m < 4; ++m) {
                const int row = brow + 16 * m + fr;
                float o[8];
#pragma unroll
                for (int e = 0; e < 8; ++e) {
                    const float gc = acc[ai][0][m][e >> 2][e & 3];
                    const float gp = (m > 0) ? acc[ai][0][m > 0 ? m - 1 : 0][e >> 2][e & 3] : gc, gn = (m < 3) ? acc[ai][0][m < 3 ? m + 1 : 3][e >> 2][e & 3] : gc;
                    const float up_in = dppf<0x121>(gc), up_ed = dppf<0x121>(gp), dn_in = dppf<0x12F>(gc), dn_ed = dppf<0x12F>(gn);
                    const float up = (fr == 0) ? up_ed : up_in, dn = (fr == 15) ? dn_ed : dn_in;
                    o[e] = gelu_tanh_f(w0[e] * up + w1[e] * gc + w2[e] * dn) * acc[ai][1][m][e >> 2][e & 3];
                }
                const bool first = (m == 0 && fr == 0), lastr = (m == 3 && fr == 15);
                if (!first && !lastr) { u32x4 w; w.x = pkbf(o[0], o[1]); w.y = pkbf(o[2], o[3]); w.z = pkbf(o[4], o[5]); w.w = pkbf(o[6], o[7]); *(u32x4*)(ACT + (size_t)row * FF + ch0) = w; }
                if ((m == 0 && fr < 2) || (m == 3 && fr > 13)) {
                    const f32x4 g0 = acc[ai][0][m][0], g1 = acc[ai][0][m][1];
                    u32x4 w; w.x = pkbf(g0[0], g0[1]); w.y = pkbf(g0[2], g0[3]); w.z = pkbf(g1[0], g1[1]); w.w = pkbf(g1[2], g1[3]);
                    const int slot = (m == 0) ? fr : fr - 12;
                    *(u32x4*)(EG + ((size_t)blk * 4 + slot) * FF + ch0) = w;
                    if (first || lastr) { const f32x4 v0 = acc[ai][1][m][0], v1 = acc[ai][1][m][1];
                        u32x4 x; x.x = pkbf(v0[0], v0[1]); x.y = pkbf(v0[2], v0[3]); x.z = pkbf(v1[0], v1[1]); x.w = pkbf(v1[2], v1[3]);
                        *(u32x4*)(EV + ((size_t)blk * 2 + (first ? 0 : 1)) * FF + ch0) = x; }
                }
            }
        }
    }
};
__device__ __forceinline__ void transpose_item(const float* __restrict__ W, int K, int N, bf16* __restrict__ WT, int item, int nperm, LAS float* scr, int lane) {
    const int nblk = N >> 6, kb = item / nblk, nb = item - kb * nblk, k0 = kb * 64, n0 = nb * 64;
    f32x4 v[16];
    const float* src = W + (size_t)(k0 + (lane >> 4)) * N + n0 + (lane & 15) * 4;
#pragma unroll
    for (int i = 0; i < 16; ++i) v[i] = *(const f32x4*)(src + (size_t)(4 * i) * N);
    __builtin_amdgcn_sched_barrier(0);
#pragma unroll
    for (int i = 0; i < 16; ++i) *(LAS f32x4*)(scr + (4 * i + (lane >> 4)) * 68 + (lane & 15) * 4) = v[i];
    LDS_WAIT();
    const int c = lane & 7;
#pragma unroll
    for (int j = 0; j < 8; ++j) { const int n = (lane >> 3) + 8 * j; const LAS float* s = scr + (8 * c) * 68 + n;
        u32x4 o; o.x = pkbf(s[0], s[68]); o.y = pkbf(s[2 * 68], s[3 * 68]); o.z = pkbf(s[4 * 68], s[5 * 68]); o.w = pkbf(s[6 * 68], s[7 * 68]);
        int nd = n; if (n0 < nperm) nd = 2 * (16 * (n >> 5) + (n & 15)) + ((n >> 4) & 1);
        *(u32x4*)(WT + (size_t)(n0 + nd) * K + k0 + 8 * c) = o; }
    LDS_WAIT();
}

__device__ __forceinline__ void transpose_wg_item(const float* __restrict__ W, int K, int N, bf16* __restrict__ WT, int item, int mode  , LAS float* scr, int tid, int ldk, int koff  ) {
    const int nblk = N >> 7, kb = item / nblk, nb = item - kb * nblk, k0 = kb * 256, n0 = nb * 128;
    f32x4 v[16];
    const int kr = tid >> 5, n4 = (tid & 31) * 4;
    const float* src = W + (size_t)(k0 + kr) * N + n0 + n4;
#pragma unroll
    for (int i = 0; i < 16; ++i) v[i] = __builtin_nontemporal_load((const f32x4*)(src + (size_t)(16 * i) * N));
    __builtin_amdgcn_sched_barrier(0);
#pragma unroll
    for (int i = 0; i < 16; ++i) { const int k = 16 * i + kr; *(LAS f32x4*)(scr + k * 132 + (n4 ^ (((k >> 3) & 7) << 2))) = v[i]; }
    __syncthreads();
    const int c = tid & 31;
#pragma unroll
    for (int j = 0; j < 8; ++j) { const int n = (tid >> 5) + 16 * j; const LAS float* s = scr + (8 * c) * 132 + (n ^ ((c & 7) << 2));
        u32x4 o; o.x = pkbf(s[0], s[132]); o.y = pkbf(s[2 * 132], s[3 * 132]); o.z = pkbf(s[4 * 132], s[5 * 132]); o.w = pkbf(s[6 * 132], s[7 * 132]);
        int nd = n0 + n;
        if (mode == 1 && n0 < 2048) { const int d = n & 63; nd = n0 + (n & 64) + 2 * (16 * (d >> 5) + (d & 15)) + ((d >> 4) & 1); }
        if (mode == 2) nd = ((n0 % FF) >> 7) * 256 + (n0 >= FF ? 128 : 0) + n;
        __builtin_nontemporal_store(o, (u32x4*)(WT + (size_t)nd * ldk + koff + k0 + 8 * c)); }
    __syncthreads();
}

__device__ __forceinline__ void ada_items(PK P, LAS unsigned char* lds, int l, int widx, int nw) {
    int tid_ = threadIdx.x; asm volatile("" : "+v"(tid_)); const int tid = tid_;
    LAS float* sil = (LAS float*)lds;
    LAS float* red = (LAS float*)(lds + 40960);
    for (int i = tid; i < 5 * DM; i += NTHR) { const float x = (i < 4 * DM) ? P->in[I_C][i] : P->in[I_CCTX][i - 4 * DM]; sil[i] = x / (1.f + __expf(-x)); }
    __syncthreads();
    float* ADA = (float*)(P->ws + WS_ADA);
    const int kg = tid >> 4, n4 = (tid & 15) * 4;
    for (int it = widx; it < 192; it += nw) {
        const int n0 = it * 64;
        const float* wp = P->in[I_WADA] + ((size_t)l * DM + kg) * 12288 + n0 + n4;
        f32x4 a[5];
#pragma unroll
        for (int r = 0; r < 5; ++r) a[r] = (f32x4){0.f, 0.f, 0.f, 0.f};
#pragma unroll 1
        for (int kk0 = 0; kk0 < 64; kk0 += 8) {
            f32x4 w[8];
#pragma unroll
            for (int j = 0; j < 8; ++j) w[j] = __builtin_nontemporal_load((const f32x4*)(wp + (size_t)(32 * (kk0 + j)) * 12288));
            __builtin_amdgcn_sched_barrier(0);
#pragma unroll
            for (int j = 0; j < 8; ++j) { const int k = kg + 32 * (kk0 + j);
#pragma unroll
                for (int r = 0; r < 5; ++r) a[r] += w[j] * sil[r * DM + k]; }
            __builtin_amdgcn_sched_barrier(0);
        }
#pragma unroll
        for (int r = 0; r < 5; ++r) *(LAS f32x4*)(red + (kg * 5 + r) * 64 + n4) = a[r];
        __syncthreads();
        if (tid < 320) { const int r = tid >> 6, n = tid & 63; float s = 0.f;
#pragma unroll 8
            for (int g = 0; g < 32; ++g) s += red[(g * 5 + r) * 64 + n];
            ADA[((size_t)l * 5 + r) * 12288 + n0 + n] = s + P->in[I_BADA][(size_t)l * 12288 + n0 + n]; }
        __syncthreads();
    }
}
__device__ __forceinline__ void filter_items(PK P, LAS unsigned char* lds, int l, int widx, int nw) {
    int tid_ = threadIdx.x; asm volatile("" : "+v"(tid_)); const int tid = tid_;
    unsigned char* ws = P->ws;
    LAS float* zs = (LAS float*)lds;
    LAS float* h1s = (LAS float*)(lds + 8192);
    LAS float* h2s = (LAS float*)(lds + 16384);
    LAS float* w1s = (LAS float*)(lds + 24576);
    LAS float* w2s = (LAS float*)(lds + 36864);
    const int NI = 256 + ((l < DEPTH - 1) ? 32 : 0);
    __syncthreads();
    if (widx < NI) {
        const float* w1 = P->in[I_HW1] + (size_t)l * 33 * 64; const float* w2 = P->in[I_HW2] + (size_t)l * 64 * 64;
        for (int i = tid; i < 33 * 16; i += NTHR) *(LAS f32x4*)(w1s + 4 * i) = *(const f32x4*)(w1 + 4 * i);
        for (int i = tid; i < 64 * 16; i += NTHR) *(LAS f32x4*)(w2s + 4 * i) = *(const f32x4*)(w2 + 4 * i);
    }
    __syncthreads();
    for (int it = widx; it < NI; it += nw) {
        int lag0, combo, L;
        if (it < 256) { lag0 = (it >> 2) * 32; combo = it & 3; L = SEQ; }
        else { const int j = it - 256; lag0 = (j >> 2) * 32; combo = j & 3; L = CTX; }
        { const int li = tid >> 4, j = tid & 15; const float lagf = (float)(lag0 + li);
          const float wang = 6.283185307179586f * lagf / (float)L; const float f = 1e-4f + (float)j * ((15.f - 1e-4f) / 15.f);
          zs[li * 36 + 1 + j] = cosf(f * wang); zs[li * 36 + 17 + j] = -sinf(f * wang); if (j == 0) zs[li * 36] = lagf / (float)(L - 1); }
        __syncthreads();
        { const int li = tid >> 4, u0 = (tid & 15) * 4; f32x4 s = *(const f32x4*)(P->in[I_HB1] + l * 64 + u0);
#pragma unroll 3
          for (int k = 0; k < 33; ++k) s += *(const LAS f32x4*)(w1s + k * 64 + u0) * zs[li * 36 + k];
          const f32x4 fr = *(const f32x4*)(P->in[I_HFREQ] + l * 128 + u0);
          f32x4 o; o.x = sinf(fr.x * s.x); o.y = sinf(fr.y * s.y); o.z = sinf(fr.z * s.z); o.w = sinf(fr.w * s.w); *(LAS f32x4*)(h1s + li * 64 + u0) = o; }
        __syncthreads();
        { const int li = tid >> 4, u0 = (tid & 15) * 4; f32x4 s = *(const f32x4*)(P->in[I_HB2] + l * 64 + u0);
#pragma unroll 4
          for (int k = 0; k < 64; ++k) s += *(const LAS f32x4*)(w2s + k * 64 + u0) * h1s[li * 64 + k];
          const f32x4 fr = *(const f32x4*)(P->in[I_HFREQ] + l * 128 + 64 + u0);
          f32x4 o; o.x = sinf(fr.x * s.x); o.y = sinf(fr.y * s.y); o.z = sinf(fr.z * s.z); o.w = sinf(fr.w * s.w); *(LAS f32x4*)(h2s + li * 64 + u0) = o; }
        __syncthreads();
        {
            const int lane = tid & 63, wv = tid >> 6, r32 = lane & 31, hh = lane >> 5, dir = combo >> 1, o = combo & 1;
            bf16x8 ah[4], al[4];
#pragma unroll
            for (int ks = 0; ks < 4; ++ks) { const LAS float* hp = h2s + r32 * 64 + 16 * ks + 8 * hh; const f32x4 x0 = *(const LAS f32x4*)hp, x1 = *(const LAS f32x4*)(hp + 4);
                const float xv[8] = {x0.x, x0.y, x0.z, x0.w, x1.x, x1.y, x1.z, x1.w}; u32x4 hi4, lo4;
#pragma unroll
                for (int q = 0; q < 4; ++q) { const unsigned h2p = pkbf(xv[2 * q], xv[2 * q + 1]); hi4[q] = h2p; lo4[q] = pkbf(xv[2 * q] - bflo(h2p), xv[2 * q + 1] - bfhi(h2p)); }
                ah[ks] = __builtin_bit_cast(bf16x8, hi4); al[ks] = __builtin_bit_cast(bf16x8, lo4); }
            const float dmin = -3.0701134573253946f, dmax = -15.350567286626973f;
#pragma unroll 1
            for (int nb = 0; nb < 2; ++nb) {
                const int c = (2 * wv + nb) * 32 + r32;
                const float* w3 = P->in[I_HW3] + (size_t)l * 64 * 2048 + combo * 512 + c;
                float wv32[32];
#pragma unroll
                for (int q = 0; q < 32; ++q) wv32[q] = w3[(size_t)(16 * (q >> 3) + 8 * hh + (q & 7)) * 2048];
                f32x16 acc = (f32x16){};
#pragma unroll
                for (int ks = 0; ks < 4; ++ks) {
                    u32x4 hi4, lo4;
#pragma unroll
                    for (int q = 0; q < 4; ++q) { const float a_ = wv32[8 * ks + 2 * q], b_ = wv32[8 * ks + 2 * q + 1]; const unsigned hp2 = pkbf(a_, b_); hi4[q] = hp2; lo4[q] = pkbf(a_ - bflo(hp2), b_ - bfhi(hp2)); }
                    const bf16x8 bh = __builtin_bit_cast(bf16x8, hi4), bl = __builtin_bit_cast(bf16x8, lo4);
                    acc = __builtin_amdgcn_mfma_f32_32x32x16_bf16(ah[ks], bh, acc, 0, 0, 0);
                    acc = __builtin_amdgcn_mfma_f32_32x32x16_bf16(ah[ks], bl, acc, 0, 0, 0);
                    acc = __builtin_amdgcn_mfma_f32_32x32x16_bf16(al[ks], bh, acc, 0, 0, 0); }
                const float delta = fabsf(dmin + (dmax - dmin) * ((float)c / 511.f));
                float* kf = (L == SEQ) ? (float*)(ws + WS_KF) + ((size_t)(l * 2 + o) * 512 + c) * 4096 : (float*)(ws + WS_KFC) + ((size_t)(l * 2 + o) * 512 + c) * 512;
                const float dl2 = -delta * 1.4426950408889634f / (float)(L - 1);
#pragma unroll
                for (int rr = 0; rr < 4; ++rr) { const int lagb = lag0 + 8 * rr + 4 * hh;
                    f32x4 v;
#pragma unroll
                    for (int i = 0; i < 4; ++i) v[i] = acc[4 * rr + i] * exp2f(dl2 * (float)(lagb + i));
                    if (dir == 0) *(f32x4*)(kf + L + lagb) = v;
                    else { if (lagb > 0) kf[L - lagb] = v[0]; kf[L - lagb - 1] = v[1]; kf[L - lagb - 2] = v[2]; kf[L - lagb - 3] = v[3]; } }
            }
        }
        __syncthreads();
    }
}
constexpr int CI_IN = 8 * 88, CI_AO = 4 * 16, CI_HO = 2 * 16, CI_PO = 2 * 16, CI_OUT = 8 * 16, CI_UP = 8 * 88, CI_DN = 22 * 16;
constexpr int CONV_ALL = CI_IN + CI_AO + CI_HO + CI_PO + CI_OUT + CI_UP + CI_DN + 1;
#ifndef CONV_CB
#define CONV_CB 4
#endif
struct ConvIt { const float* src; bf16* WT; int N, n0, k0, mode, ldk, koff; };
__device__ __forceinline__ ConvIt conv_decode(PK P, unsigned char* lw, int l, int it, int tid) {
    int r = it;
    const float* W; int K, N; bf16* WT; int mode = 0, ldk = 0, koff = 0;
    if (r < CI_IN) { W = P->in[I_WIN] + (size_t)l * DM * INW; K = DM; N = INW; WT = (bf16*)(lw + LW_WIN); mode = 1; }
    else if ((r -= CI_IN) < CI_AO) { W = P->in[I_WAO] + (size_t)l * AW * DM; K = AW; N = DM; WT = (bf16*)(lw + LW_WAO); ldk = DM; }
    else if ((r -= CI_AO) < CI_HO) { W = P->in[I_WHO] + (size_t)l * HWD * DM; K = HWD; N = DM; WT = (bf16*)(lw + LW_WAO); ldk = DM; koff = 1024; }
    else if ((r -= CI_HO) < CI_PO) { W = P->in[I_WPO] + (size_t)l * PWD * DM; K = PWD; N = DM; WT = (bf16*)(lw + LW_WAO); ldk = DM; koff = 1536; }
    else if ((r -= CI_PO) < CI_OUT) { W = P->in[I_WOUT] + (size_t)l * DM * DM; K = DM; N = DM; WT = (bf16*)(lw + LW_WOUT); }
    else if ((r -= CI_OUT) < CI_UP) { W = P->in[I_WUP] + (size_t)l * DM * INW; K = DM; N = INW; WT = (bf16*)(lw + LW_WUP); mode = 2; }
    else { r -= CI_UP; W = P->in[I_WDN] + (size_t)l * FF * DM; K = FF; N = DM; WT = (bf16*)(lw + LW_WDN); }
    const int nblk = N >> 7, kb = r / nblk, nb = r - kb * nblk;
    ConvIt c; c.N = N; c.n0 = nb * 128; c.k0 = kb * 256; c.mode = mode; c.ldk = ldk ? ldk : K; c.koff = koff; c.WT = WT;
    c.src = W + (size_t)(c.k0 + (tid >> 5)) * N + c.n0 + (tid & 31) * 4;
    return c;
}
__device__ __forceinline__ void conv_items(PK P, LAS unsigned char* lds, int l, int lo, int hi, int widx, int nw) {
    int tid_ = threadIdx.x; asm volatile("" : "+v"(tid_)); const int tid = tid_, lane = tid & 63, wid = rfl(tid >> 6);
    LAS float* scr = (LAS float*)lds;
    unsigned char* lw = P->ws + WS_W + (size_t)l * LW_SIZE;
    __syncthreads();
    const int hi2 = hi < CONV_ALL - 1 ? hi : CONV_ALL - 1;
    int it = lo + widx;
    const int kr = tid >> 5, n4 = (tid & 31) * 4, c = tid & 31;
    while (it < hi2) {
        const ConvIt cur = conv_decode(P, lw, l, it, tid);
#pragma unroll
        for (int b0 = 0; b0 < 16; b0 += CONV_CB) {
            f32x4 v[CONV_CB];
#pragma unroll
            for (int i = 0; i < CONV_CB; ++i) v[i] = __builtin_nontemporal_load((const f32x4*)(cur.src + (size_t)(16 * (b0 + i)) * cur.N));
            __builtin_amdgcn_sched_barrier(0);
#pragma unroll
            for (int i = 0; i < CONV_CB; ++i) { const int k = 16 * (b0 + i) + kr; *(LAS f32x4*)(scr + k * 132 + (n4 ^ (((k >> 3) & 7) << 2))) = v[i]; }
            __builtin_amdgcn_sched_barrier(0);
        }
        __syncthreads();
#pragma unroll
        for (int j = 0; j < 8; ++j) { const int n = (tid >> 5) + 16 * j; const LAS float* s = scr + (8 * c) * 132 + (n ^ ((c & 7) << 2));
            u32x4 o; o.x = pkbf(s[0], s[132]); o.y = pkbf(s[2 * 132], s[3 * 132]); o.z = pkbf(s[4 * 132], s[5 * 132]); o.w = pkbf(s[6 * 132], s[7 * 132]);
            int nd = cur.n0 + n;
            if (cur.mode == 1 && cur.n0 < 2048) { const int d = n & 63; nd = cur.n0 + (n & 64) + 2 * (16 * (d >> 5) + (d & 15)) + ((d >> 4) & 1); }
            if (cur.mode == 2) nd = ((cur.n0 % FF) >> 7) * 256 + (cur.n0 >= FF ? 128 : 0) + n;
            __builtin_nontemporal_store(o, (u32x4*)(cur.WT + (size_t)nd * cur.ldk + cur.koff + cur.k0 + 8 * c)); }
        __syncthreads();
        it += nw;
    }
    if (lo <= CONV_ALL - 1 && CONV_ALL - 1 < hi && (CONV_ALL - 1 - lo) % nw == widx) {
        LAS float* ws_ = (LAS float*)(lds + wid * 17408);
        for (int q = wid; q < 16; q += NWAVES) { const int g = q >> 2; transpose_item(P->in[I_POOLW] + ((size_t)l * 4 + g) * 128 * 128, 128, 128, (bf16*)(lw + LW_PWT) + (size_t)g * 128 * 128, q & 3, 0, ws_, lane); }
    }
    __syncthreads();
}
__device__ __forceinline__ void misc_tables(PK P) {
    int tid_ = threadIdx.x; asm volatile("" : "+v"(tid_)); const int tid = tid_, lane = tid & 63, wid = rfl(tid >> 6);
    unsigned char* ws = P->ws;
    float* rc = (float*)(ws + WS_ROPE); float* rs = rc + 1024;
    for (int i = tid; i < 1024; i += NTHR) { const int pos = i >> 4, f = i & 15; const float inv = powf(10000.f, -(float)f / 16.f); const float ang = (float)pos * inv; rc[i] = cosf(ang); rs[i] = sinf(ang); }
    if (wid < DEPTH) { const float* lp = P->in[I_DLAM] + wid * 256; const float s1 = wave_sum(lp[lane] * lp[64 + lane]), s2 = wave_sum(lp[128 + lane] * lp[192 + lane]);
        const float li = 0.8f - 0.6f * expf(-0.3f * (float)wid);
        if (lane == 0) { float* sc = (float*)(ws + WS_SC); sc[wid * 2] = expf(s1) - expf(s2) + li; sc[wid * 2 + 1] = 1.f - li; } }
}
__device__ __forceinline__ void prologue_phase(PK P, LAS unsigned char* lds, int vcu, int G) {
    ada_items(P, lds, 0, vcu, G);
    if (vcu == 0) misc_tables(P);
    filter_items(P, lds, 0, vcu, G);
    conv_items(P, lds, 0, 0, CONV_ALL, vcu, G);
}
template <int MODE>
__device__ __forceinline__ void norm_phase(PK P, int vcu, int G, int nrows, const float* __restrict__ ada_l  , int jA,
                                           const float* __restrict__ gA, const bf16* __restrict__ Y, float* out_f32  , bool want_h,
                                           const float* __restrict__ ada_h  , int jShift, int jScale, const float* __restrict__ gB,
                                           const float* __restrict__ slab = nullptr, int nslab = 0  ) {
    int tid_ = threadIdx.x; asm volatile("" : "+v"(tid_)); const int tid = tid_, lane = tid & 63, wid = rfl(tid >> 6);
    bf16* XRES = (bf16*)(P->ws + WS_XRES); bf16* H = (bf16*)(P->ws + WS_H);
    const int stride = G * NWAVES, gw = vcu * NWAVES + wid;
    const bool deal = (nrows == RT) && (stride == 2048);
    const int per = (!deal && nrows % stride == 0) ? nrows / stride : 0;
    const int nmine = deal ? (gw < 1024 ? 4 : 5) : (per ? per : (nrows - gw + stride - 1) / stride);
#define NP_ROW(i) (deal ? (gw < 1024 ? ((i) == 0 ? RX + gw : 3 * gw + ((i) - 1)) : 3072 + 5 * (gw - 1024) + (i)) : (per ? per * gw + (i) : gw + stride * (i)))
    f32x4 xn[8]; u32x2 yn[8], xr2[8];
#define NP_LOAD(r) do { const int r_ = (r); \
        if (MODE == 0) { const float* xr_ = (r_ < RX) ? P->in[I_X] + (size_t)r_ * DM : P->in[I_CTX] + (size_t)(r_ - RX) * DM; \
            _Pragma("unroll") for (int j = 0; j < 8; ++j) xn[j] = *(const f32x4*)(xr_ + 4 * (lane + 64 * j)); } \
        else { const bf16* xr_ = XRES + (size_t)r_ * DM; const bf16* yr_ = Y + (size_t)r_ * DM; \
            _Pragma("unroll") for (int j = 0; j < 8; ++j) { xr2[j] = *(const u32x2*)(xr_ + 4 * (lane + 64 * j)); \
                if (r_ < RX || nslab == 0) yn[j] = *(const u32x2*)(yr_ + 4 * (lane + 64 * j)); } } __builtin_amdgcn_sched_barrier(0); } while (0)
    if (nmine > 0) NP_LOAD(NP_ROW(0));
    f32x4 mg[8], sg[8], sh8[8];
    int acur = -1;
    for (int it = 0; it < nmine; ++it) {
        const int row = NP_ROW(it);
        const int arow = (row < RX) ? (row >> 11) : 4;
        if (arow != acur) {
            acur = arow;
            int lq = lane; asm volatile("" : "+v"(lq));
            if (MODE != 0) { const float* mA = ada_l + (size_t)arow * 12288 + jA * DM;
#pragma unroll
                for (int j0 = 0; j0 < 8; j0 += 4) { f32x4 m[4], g[4];
#pragma unroll
                    for (int j = 0; j < 4; ++j) { const int e = 4 * (lq + 64 * (j0 + j)); m[j] = *(const f32x4*)(mA + e); g[j] = *(const f32x4*)(gA + e); }
                    __builtin_amdgcn_sched_barrier(0);
#pragma unroll
                    for (int j = 0; j < 4; ++j) mg[j0 + j] = m[j] * g[j];
                    __builtin_amdgcn_sched_barrier(0); } }
            if (want_h) { const float* mSh = ada_h + (size_t)arow * 12288 + jShift * DM; const float* mSc = ada_h + (size_t)arow * 12288 + jScale * DM;
#pragma unroll
                for (int j0 = 0; j0 < 8; j0 += 4) { f32x4 sc[4], g[4];
#pragma unroll
                    for (int j = 0; j < 4; ++j) { const int e = 4 * (lq + 64 * (j0 + j)); sh8[j0 + j] = *(const f32x4*)(mSh + e); sc[j] = *(const f32x4*)(mSc + e); g[j] = *(const f32x4*)(gB + e); }
                    __builtin_amdgcn_sched_barrier(0);
#pragma unroll
                    for (int j = 0; j < 4; ++j) sg[j0 + j] = g[j] * (sc[j] + 1.f);
                    __builtin_amdgcn_sched_barrier(0); } }
        }
        f32x4 x[8];
#pragma unroll
        for (int j = 0; j < 8; ++j) x[j] = (MODE == 0) ? xn[j] : (f32x4){bflo(xr2[j].x), bfhi(xr2[j].x), bflo(xr2[j].y), bfhi(xr2[j].y)};
        if (MODE != 0) {
            f32x4 y[8]; float ss = 0.f;
#pragma unroll
            for (int j = 0; j < 8; ++j) {
                if (row < RX || nslab == 0) y[j] = (f32x4){bflo(yn[j].x), bfhi(yn[j].x), bflo(yn[j].y), bfhi(yn[j].y)};
                else { const bf16* sp = (const bf16*)slab + (size_t)(row - RX) * DM + 4 * (lane + 64 * j); y[j] = (f32x4){0.f, 0.f, 0.f, 0.f};
                    for (int s = 0; s < nslab; ++s) { const u32x2 u = *(const u32x2*)(sp + (size_t)s * RC * DM); y[j] += (f32x4){bflo(u.x), bfhi(u.x), bflo(u.y), bfhi(u.y)}; } }
                ss += (y[j].x * y[j].x + y[j].y * y[j].y) + (y[j].z * y[j].z + y[j].w * y[j].w); }
            const float rstd = rsqrtf(wave_sum(ss) * (1.f / DM) + EPS);
#pragma unroll
            for (int j = 0; j < 8; ++j) x[j] += mg[j] * (y[j] * rstd);
            __builtin_amdgcn_sched_barrier(0);
            if (it + 1 < nmine) NP_LOAD(NP_ROW(it + 1));
        } else { if (it + 1 < nmine) NP_LOAD(NP_ROW(it + 1)); }
        if (out_f32) { float* xo = out_f32 + (size_t)row * DM;
#pragma unroll
          for (int j = 0; j < 8; ++j) *(f32x4*)(xo + 4 * (lane + 64 * j)) = x[j]; }
        else { bf16* xo = XRES + (size_t)row * DM;
#pragma unroll
          for (int j = 0; j < 8; ++j) { u32x2 o; o.x = pkbf(x[j].x, x[j].y); o.y = pkbf(x[j].z, x[j].w); *(u32x2*)(xo + 4 * (lane + 64 * j)) = o;
              x[j] = (f32x4){bflo(o.x), bfhi(o.x), bflo(o.y), bfhi(o.y)}; } }
        if (want_h) {
            float ss = 0.f;
#pragma unroll
            for (int j = 0; j < 8; ++j) ss += (x[j].x * x[j].x + x[j].y * x[j].y) + (x[j].z * x[j].z + x[j].w * x[j].w);
            const float rstd = rsqrtf(wave_sum(ss) * (1.f / DM) + EPS);
            bf16* hr = H + (size_t)row * DM;
#pragma unroll
            for (int j = 0; j < 8; ++j) { const int e = 4 * (lane + 64 * j); const f32x4 h = (x[j] * rstd) * sg[j] + sh8[j]; u32x2 o; o.x = pkbf(h.x, h.y); o.y = pkbf(h.z, h.w); *(u32x2*)(hr + e) = o; }
        }
    }
#undef NP_LOAD
#undef NP_ROW
}

__device__ __forceinline__ void act_edge_phase(PK P, int vcu, int G, int nrows, const float* __restrict__ cw  ) {
    int tid_ = threadIdx.x; asm volatile("" : "+v"(tid_)); const int tid = tid_;
    const bf16* EG = (const bf16*)(P->ws + WS_EG); const bf16* EV = (const bf16*)(P->ws + WS_EV); bf16* ACT = (bf16*)(P->ws + WS_ACT);
    const int nblk = nrows >> 6, nitems = nblk * 2 * (FF / 8);
    for (int it = vcu * NTHR + tid; it < nitems; it += G * NTHR) {
        const int cch = it % (FF / 8), rb = it / (FF / 8), b = rb >> 1, lastr = rb & 1, ch = cch * 8;
        const int row = b * 64 + (lastr ? 63 : 0);
        const int tq = (row < RX) ? (row & (SEQ - 1)) : ((row - RX) & (CTX - 1)); const int Ls = (row < RX) ? SEQ : CTX;
        u32x4 up = {0u, 0u, 0u, 0u}, dn = {0u, 0u, 0u, 0u}, cur, vv;
        if (!lastr) { cur = *(const u32x4*)(EG + ((size_t)b * 4 + 0) * FF + ch); dn = *(const u32x4*)(EG + ((size_t)b * 4 + 1) * FF + ch); vv = *(const u32x4*)(EV + ((size_t)b * 2 + 0) * FF + ch);
            if (tq > 0) up = *(const u32x4*)(EG + ((size_t)(b - 1) * 4 + 3) * FF + ch); }
        else { cur = *(const u32x4*)(EG + ((size_t)b * 4 + 3) * FF + ch); up = *(const u32x4*)(EG + ((size_t)b * 4 + 2) * FF + ch); vv = *(const u32x4*)(EV + ((size_t)b * 2 + 1) * FF + ch);
            if (tq + 1 < Ls) dn = *(const u32x4*)(EG + ((size_t)(b + 1) * 4 + 0) * FF + ch); }
        float w0[8], w1[8], w2[8];
#pragma unroll
        for (int i = 0; i < 8; i += 4) { *(f32x4*)(w0 + i) = *(const f32x4*)(cw + ch + i); *(f32x4*)(w1 + i) = *(const f32x4*)(cw + FF + ch + i); *(f32x4*)(w2 + i) = *(const f32x4*)(cw + 2 * FF + ch + i); }
        float o[8];
#pragma unroll
        for (int q = 0; q < 4; ++q) {
            o[2 * q] = gelu_tanh_f(w0[2 * q] * bflo(up[q]) + w1[2 * q] * bflo(cur[q]) + w2[2 * q] * bflo(dn[q])) * bflo(vv[q]);
            o[2 * q + 1] = gelu_tanh_f(w0[2 * q + 1] * bfhi(up[q]) + w1[2 * q + 1] * bfhi(cur[q]) + w2[2 * q + 1] * bfhi(dn[q])) * bfhi(vv[q]);
        }
        u32x4 w; w.x = pkbf(o[0], o[1]); w.y = pkbf(o[2], o[3]); w.z = pkbf(o[4], o[5]); w.w = pkbf(o[6], o[7]);
        *(u32x4*)(ACT + (size_t)row * FF + ch) = w;
    }
}

constexpr int AT_STAGE = 32768;
__device__ __forceinline__ s16x4 vtr(const LAS unsigned char* p) { typedef short v4i16_t __attribute__((ext_vector_type(4))); return __builtin_bit_cast(s16x4, __builtin_amdgcn_ds_read_tr16_b64_v4i16((LAS v4i16_t*)p)); }

#define DS_RD128(dst, addr, OFF) asm volatile("ds_read_b128 %0, %1 offset:%2" : "=&v"(dst) : "v"(addr), "n"(OFF))
#define DS_RDTR(dst, addr, OFF) asm volatile("ds_read_b64_tr_b16 %0, %1 offset:%2" : "=&v"(dst) : "v"(addr), "n"(OFF))
#define V_READ(S, blk) do { DS_RDTR(S[0], vaddr, ((blk) * 4 + 0) * 1024); DS_RDTR(S[1], vaddr, ((blk) * 4 + 0) * 1024 + 512); DS_RDTR(S[2], vaddr, ((blk) * 4 + 1) * 1024); DS_RDTR(S[3], vaddr, ((blk) * 4 + 1) * 1024 + 512); \
        DS_RDTR(S[4], vaddr, ((blk) * 4 + 2) * 1024); DS_RDTR(S[5], vaddr, ((blk) * 4 + 2) * 1024 + 512); DS_RDTR(S[6], vaddr, ((blk) * 4 + 3) * 1024); DS_RDTR(S[7], vaddr, ((blk) * 4 + 3) * 1024 + 512); } while (0)
#define V_WAIT(N, S) asm volatile("s_waitcnt lgkmcnt(" #N ")" : "+v"(S[0]), "+v"(S[1]), "+v"(S[2]), "+v"(S[3]), "+v"(S[4]), "+v"(S[5]), "+v"(S[6]), "+v"(S[7]))
#define PV4(blk, S) do { _Pragma("unroll") for (int ks_ = 0; ks_ < 4; ++ks_) { const bf16x8 vf_ = {S[2 * ks_][0], S[2 * ks_][1], S[2 * ks_][2], S[2 * ks_][3], S[2 * ks_ + 1][0], S[2 * ks_ + 1][1], S[2 * ks_ + 1][2], S[2 * ks_ + 1][3]}; \
        o[blk] = __builtin_amdgcn_mfma_f32_32x32x16_bf16(vf_, __builtin_bit_cast(bf16x8, pw[ks_]), o[blk], 0, 0, 0); } } while (0)
__device__ __forceinline__ void attn_unit(LAS unsigned char* lds, const bf16* __restrict__ QKV, bf16* __restrict__ MIXA, float lam, float oscale, const float* __restrict__ subg,
                                          int b, int h, int qb, bool isctx) {
    int tid_ = threadIdx.x; asm volatile("" : "+v"(tid_)); const int tid = tid_, lane = tid & 63, wid = rfl(tid >> 6), r32 = lane & 31, hi = lane >> 5;
    const int mp = wid & 1, g = wid >> 1;
    const int seq0 = isctx ? RX + b * CTX : b * SEQ, ctx0 = RX + b * CTX;
    const int qrow = seq0 + qb * 128 + g * 32 + r32;
    const int NT = isctx ? 4 : 36;
    bf16x8 qf[4];
    { const bf16* qp = QKV + (size_t)qrow * NQKV + h * 128 + mp * 64 + hi * 8;
#pragma unroll
      for (int d0 = 0; d0 < 4; ++d0) qf[d0] = *(const bf16x8*)(qp + d0 * 16); }
    const int kkey = 8 * wid + (lane >> 3);
    const bf16* kbase = QKV + 1024 + h * 128 + (size_t)kkey * NQKV + (((lane & 7) ^ ((kkey >> 1) & 7)) << 3);
    const bf16* vbase = QKV + 2048 + h * 128 + (wid >> 1) * 32 + (lane & 3) * 8;
    const int vrow = 16 * ((2 * wid) & 3) + (lane >> 2);
    const int kdst = wid * 1024 + lane * 16, vdst = 16384 + (2 * wid) * 1024 + lane * 16;
#define AT_KROW(t) (isctx ? seq0 + 64 * (t) : ((t) < 32 ? seq0 + 64 * (t) : ctx0 + 64 * ((t) - 32)))
#define AT_DMA(t, st) do { const int kr_ = AT_KROW(t); LAS unsigned char* b_ = lds + (st) * AT_STAGE; const bf16* kp_ = kbase + (size_t)kr_ * NQKV; const bf16* vp_ = vbase + (size_t)(kr_ + vrow) * NQKV; \
        __builtin_amdgcn_global_load_lds((const unsigned*)kp_, (LAS unsigned*)(b_ + wid * 1024), 16, 0, 0); \
        __builtin_amdgcn_global_load_lds((const unsigned*)(kp_ + 64), (LAS unsigned*)(b_ + 8192 + wid * 1024), 16, 0, 0); \
        __builtin_amdgcn_global_load_lds((const unsigned*)vp_, (LAS unsigned*)(b_ + 16384 + (2 * wid) * 1024), 16, 0, 0); \
        __builtin_amdgcn_global_load_lds((const unsigned*)(vp_ + (size_t)16 * NQKV), (LAS unsigned*)(b_ + 16384 + (2 * wid + 1) * 1024), 16, 0, 0); } while (0)
#define AT_BAR(N) do { asm volatile("s_waitcnt vmcnt(" #N ")" ::: "memory"); __builtin_amdgcn_s_barrier(); asm volatile("" ::: "memory"); } while (0)
    AT_DMA(0, 0); if (NT > 1) AT_DMA(1, 1);
    if (NT > 1) AT_BAR(4); else AT_BAR(0);
    f32x16 o[4];
#pragma unroll
    for (int i = 0; i < 4; ++i) o[i] = (f32x16){};
    float mref = 0.f, lrun = 0.f;
    f32x16 negm = (f32x16){};
    int kofs[4];
#pragma unroll
    for (int d0 = 0; d0 < 4; ++d0) kofs[d0] = mp * 8192 + r32 * 128 + (((2 * d0 + hi) ^ ((r32 >> 1) & 7)) << 4);
    const int voff = 16384 + (4 * hi + ((lane & 15) >> 2)) * 64 + ((lane >> 4) & 1) * 32 + (lane & 3) * 8;
    u32x4 pw[4];
    int sc = 0, sp = 2;
#define QK_TILE() \
        f32x16 p0 = negm, p1 = negm; \
        { const unsigned kst = (unsigned)(uintptr_t)(lds + sc * AT_STAGE); bf16x8 kf[8]; \
          DS_RD128(kf[0], kst + kofs[0], 0); DS_RD128(kf[1], kst + kofs[0], 4096); DS_RD128(kf[2], kst + kofs[1], 0); DS_RD128(kf[3], kst + kofs[1], 4096); \
          DS_RD128(kf[4], kst + kofs[2], 0); DS_RD128(kf[5], kst + kofs[2], 4096); DS_RD128(kf[6], kst + kofs[3], 0); DS_RD128(kf[7], kst + kofs[3], 4096); \
          asm volatile("s_waitcnt lgkmcnt(6)" : "+v"(kf[0]), "+v"(kf[1])); \
          p0 = __builtin_amdgcn_mfma_f32_32x32x16_bf16(kf[0], qf[0], p0, 0, 0, 0); p1 = __builtin_amdgcn_mfma_f32_32x32x16_bf16(kf[1], qf[0], p1, 0, 0, 0); \
          asm volatile("s_waitcnt lgkmcnt(4)" : "+v"(kf[2]), "+v"(kf[3])); \
          p0 = __builtin_amdgcn_mfma_f32_32x32x16_bf16(kf[2], qf[1], p0, 0, 0, 0); p1 = __builtin_amdgcn_mfma_f32_32x32x16_bf16(kf[3], qf[1], p1, 0, 0, 0); \
          asm volatile("s_waitcnt lgkmcnt(2)" : "+v"(kf[4]), "+v"(kf[5])); \
          p0 = __builtin_amdgcn_mfma_f32_32x32x16_bf16(kf[4], qf[2], p0, 0, 0, 0); p1 = __builtin_amdgcn_mfma_f32_32x32x16_bf16(kf[5], qf[2], p1, 0, 0, 0); \
          asm volatile("s_waitcnt lgkmcnt(0)" : "+v"(kf[6]), "+v"(kf[7])); \
          p0 = __builtin_amdgcn_mfma_f32_32x32x16_bf16(kf[6], qf[3], p0, 0, 0, 0); p1 = __builtin_amdgcn_mfma_f32_32x32x16_bf16(kf[7], qf[3], p1, 0, 0, 0); }
#define ROWMAX(rm) do { asm volatile("s_nop 15\n\ts_nop 7" : "+v"(p0), "+v"(p1)); \
        float a_ = max3f(p0[0], p0[1], p1[0]), b_ = max3f(p0[2], p0[3], p1[1]); a_ = max3f(a_, p1[2], p1[3]); \
        _Pragma("unroll") for (int r = 4; r < 16; r += 4) { a_ = max3f(a_, p0[r], p0[r + 1]); b_ = max3f(b_, p0[r + 2], p0[r + 3]); a_ = max3f(a_, p1[r], p1[r + 1]); b_ = max3f(b_, p1[r + 2], p1[r + 3]); } \
        rm = xhalf_max(max3f(a_, b_, b_)); } while (0)
#define EXP8(P, B, ls) do { _Pragma("unroll") for (int r = (B); r < (B) + 8; ++r) { P[r] = __builtin_amdgcn_exp2f(P[r]); ls += P[r]; } } while (0)
#define PACK_P() do { _Pragma("unroll") for (int s_ = 0; s_ < 2; ++s_) { \
            pw[s_] = (u32x4){pkbf(p0[8 * s_], p0[8 * s_ + 1]), pkbf(p0[8 * s_ + 2], p0[8 * s_ + 3]), pkbf(p0[8 * s_ + 4], p0[8 * s_ + 5]), pkbf(p0[8 * s_ + 6], p0[8 * s_ + 7])}; \
            pw[2 + s_] = (u32x4){pkbf(p1[8 * s_], p1[8 * s_ + 1]), pkbf(p1[8 * s_ + 2], p1[8 * s_ + 3]), pkbf(p1[8 * s_ + 4], p1[8 * s_ + 5]), pkbf(p1[8 * s_ + 6], p1[8 * s_ + 7])}; } } while (0)
    {
        if (NT > 2) AT_DMA(2, 2);
        __builtin_amdgcn_sched_barrier(0);
        QK_TILE();
        float rm; ROWMAX(rm);
        mref = rm;
#pragma unroll
        for (int r = 0; r < 16; ++r) { p0[r] -= rm; p1[r] -= rm; negm[r] = -mref; }
        float ls = 0.f; EXP8(p0, 0, ls); EXP8(p0, 8, ls); EXP8(p1, 0, ls); EXP8(p1, 8, ls);
        lrun = ls;
        PACK_P();
        __builtin_amdgcn_sched_barrier(0);
        if (NT > 2) AT_BAR(4); else AT_BAR(0);
    }
    sp = 0; sc = 1;
    for (int t = 1; t < NT; ++t) {
        if (t + 2 < NT) AT_DMA(t + 2, (sc + 2) & 3);
        __builtin_amdgcn_sched_barrier(0);
        const unsigned vaddr = (unsigned)(uintptr_t)(lds + sp * AT_STAGE + voff);
        s16x4 va[8], vb[8];
        V_READ(va, 0);
        QK_TILE();
        float rm; ROWMAX(rm);
        const bool resc = __any(rm > 8.f);
        float alpha = 1.f;
        if (__builtin_expect(resc, 0)) { asm volatile("; rescale (rare): keep this a real branch" ::: "memory");
            const float dl = fmaxf(rm, 0.f); alpha = __builtin_amdgcn_exp2f(-dl); mref += dl;
#pragma unroll
            for (int r = 0; r < 16; ++r) { p0[r] -= dl; p1[r] -= dl; negm[r] = -mref; } }
        float ls = 0.f;
#define PV_STEP(blk, S, ks, P, r0) do { const bf16x8 vf_ = {S[2 * (ks)][0], S[2 * (ks)][1], S[2 * (ks)][2], S[2 * (ks)][3], S[2 * (ks) + 1][0], S[2 * (ks) + 1][1], S[2 * (ks) + 1][2], S[2 * (ks) + 1][3]}; \
            o[blk] = __builtin_amdgcn_mfma_f32_32x32x16_bf16(vf_, __builtin_bit_cast(bf16x8, pw[ks]), o[blk], 0, 0, 0); \
            P[r0] = __builtin_amdgcn_exp2f(P[r0]); P[(r0) + 1] = __builtin_amdgcn_exp2f(P[(r0) + 1]); ls += P[r0] + P[(r0) + 1]; asm volatile("" : "+v"(P), "+v"(ls)); __builtin_amdgcn_sched_barrier(0); } while (0)
        V_READ(vb, 1); V_WAIT(8, va); PV_STEP(0, va, 0, p0, 0); PV_STEP(0, va, 1, p0, 2); PV_STEP(0, va, 2, p0, 4); PV_STEP(0, va, 3, p0, 6);
        V_READ(va, 2); V_WAIT(8, vb); PV_STEP(1, vb, 0, p0, 8); PV_STEP(1, vb, 1, p0, 10); PV_STEP(1, vb, 2, p0, 12); PV_STEP(1, vb, 3, p0, 14);
        V_READ(vb, 3); V_WAIT(8, va); PV_STEP(2, va, 0, p1, 0); PV_STEP(2, va, 1, p1, 2); PV_STEP(2, va, 2, p1, 4); PV_STEP(2, va, 3, p1, 6);
        V_WAIT(0, vb); PV_STEP(3, vb, 0, p1, 8); PV_STEP(3, vb, 1, p1, 10); PV_STEP(3, vb, 2, p1, 12); PV_STEP(3, vb, 3, p1, 14);
#undef PV_STEP
        if (__builtin_expect(resc, 0)) { asm volatile("; rescale (rare)" ::: "memory"); lrun *= alpha;
#pragma unroll
            for (int i = 0; i < 4; ++i) o[i] *= alpha; }
        lrun += ls;
        PACK_P();
        __builtin_amdgcn_sched_barrier(0);
        if (t + 2 < NT) AT_BAR(4); else AT_BAR(0);
        sp = sc; sc = (sc + 1) & 3;
    }
    {
        const unsigned vaddr = (unsigned)(uintptr_t)(lds + sp * AT_STAGE + voff);
        s16x4 va[8], vb[8];
        V_READ(va, 0);
        V_READ(vb, 1); V_WAIT(8, va); PV4(0, va);
        V_READ(va, 2); V_WAIT(8, vb); PV4(1, vb);
        V_READ(vb, 3); V_WAIT(8, va); PV4(2, va);
        V_WAIT(0, vb); PV4(3, vb);
    }
    __syncthreads();
#undef QK_TILE
#undef ROWMAX
#undef EXP8
#undef PACK_P
#undef AT_KROW
#undef AT_DMA
#undef AT_BAR
#undef DS_RD128
#undef DS_RDTR
#undef V_READ
#undef V_WAIT
#undef PV4
    const float inv = 1.f / xhalf_sum(lrun);
    LAS float* ex = (LAS float*)(lds + g * 16384) + lane;
    if (mp == 1) {
#pragma unroll
        for (int blk = 0; blk < 4; ++blk)
#pragma unroll
            for (int r = 0; r < 16; ++r) ex[(blk * 16 + r) * 64] = o[blk][r] * inv;
    }
    __syncthreads();
    if (mp == 0) {
        float ss = 0.f;
#pragma unroll
        for (int blk = 0; blk < 4; ++blk)
#pragma unroll
            for (int r = 0; r < 16; ++r) { const float d = o[blk][r] * inv - lam * ex[(blk * 16 + r) * 64]; o[blk][r] = d; ss += d * d; }
        ss = xhalf_sum(ss);
        const float rs = rsqrtf(ss * (1.f / 128.f) + EPS) * oscale;
        bf16* op = MIXA + (size_t)qrow * DM + h * 128 + 4 * hi;
#pragma unroll
        for (int blk = 0; blk < 4; ++blk)
#pragma unroll
            for (int rr = 0; rr < 4; ++rr) { const int vd = 32 * blk + 8 * rr; const f32x4 gg = *(const f32x4*)(subg + vd + 4 * hi);
                u32x2 w; w.x = pkbf(o[blk][4 * rr] * rs * gg.x, o[blk][4 * rr + 1] * rs * gg.y); w.y = pkbf(o[blk][4 * rr + 2] * rs * gg.z, o[blk][4 * rr + 3] * rs * gg.w);
                *(u32x2*)(op + vd) = w; }
    }
    __syncthreads();
}
constexpr int HY_FC = 0, HY_FCS = 8224, HY_U = 8 * HY_FCS, HY_US = 5008  , HY_XS = 4112  , HY_X1 = HY_U + 4 * HY_US, HY_X2 = HY_X1 + 4 * HY_XS,
              HY_KFS = HY_X2 + 4 * HY_XS  , HY_RED = HY_KFS + 16384 + 128, HY_END = HY_RED + 64;
static_assert(HY_END <= MISC_OFF, "hyena LDS");

struct HyRegs { u32x4 ch[3][2]; unsigned hp[3][2], hn[3][2]; float k0[8], k1[8]; };
__device__ __forceinline__ void hy_load(HyRegs& R, PK P, int l, int c, bool isctx, int tid) {
    const int L = isctx ? CTX : SEQ, row0 = isctx ? RX : 0, l8 = L >> 3, nch = 4 * l8;
    const bf16* HYT = (const bf16*)(P->ws + WS_HYT);
#pragma unroll
    for (int a = 0; a < 3; ++a)
#pragma unroll
        for (int j = 0; j < 2; ++j) {
            const int e = min(tid + NTHR * j, nch - 1);
            const int n = e / l8, t0 = (e - n * l8) * 8;
            const bf16* sp = HYT + (size_t)(a * 512 + c) * RT + row0 + (size_t)n * L + t0;
            R.ch[a][j] = *(const u32x4*)sp;
            R.hp[a][j] = *(const unsigned*)(sp + ((t0 > 0) ? -2 : 0));
            R.hn[a][j] = *(const unsigned*)(sp + ((t0 + 8 < L) ? 8 : 6));
        }
    const float* kf0 = isctx ? (const float*)(P->ws + WS_KFC) + ((size_t)(l * 2) * 512 + c) * 512 : (const float*)(P->ws + WS_KF) + ((size_t)(l * 2) * 512 + c) * 4096;
    const float* kf1 = kf0 + (isctx ? (size_t)512 * 512 : (size_t)512 * 4096);
#pragma unroll
    for (int j = 0; j < 8; ++j) { const int i = min(max(tid + NTHR * j, 1), 2 * L - 1); R.k0[j] = kf0[i]; R.k1[j] = kf1[i]; }
    __builtin_amdgcn_sched_barrier(0);
}
__device__ __forceinline__ void hy_fill_conv3(LAS unsigned char* dst, int dstS, int pad, const u32x4 (&ch)[2], const unsigned (&hp)[2], const unsigned (&hn)[2], int L, float w0, float w1, float w2, int tid) {
    const int l8 = L >> 3, nch = 4 * l8;
#pragma unroll
    for (int j = 0; j < 2; ++j) {
        const int e = tid + NTHR * j;
        if (e < nch) {
            const int n = e / l8, t0 = (e - n * l8) * 8; const u32x4 v = ch[j];
            float x[10] = {(t0 > 0) ? bfhi(hp[j]) : 0.f, bflo(v.x), bfhi(v.x), bflo(v.y), bfhi(v.y), bflo(v.z), bfhi(v.z), bflo(v.w), bfhi(v.w), (t0 + 8 < L) ? bflo(hn[j]) : 0.f};
            u32x4 o;
            o.x = pkbf(w0 * x[0] + w1 * x[1] + w2 * x[2], w0 * x[1] + w1 * x[2] + w2 * x[3]); o.y = pkbf(w0 * x[2] + w1 * x[3] + w2 * x[4], w0 * x[3] + w1 * x[4] + w2 * x[5]);
            o.z = pkbf(w0 * x[4] + w1 * x[5] + w2 * x[6], w0 * x[5] + w1 * x[6] + w2 * x[7]); o.w = pkbf(w0 * x[6] + w1 * x[7] + w2 * x[8], w0 * x[7] + w1 * x[8] + w2 * x[9]);
            *(LAS u32x4*)(dst + n * dstS + (pad + t0) * 2) = o;
        }
    }
}
__device__ __forceinline__ float hy_fill_filter(LAS unsigned char* lds, const float (&kf)[8], int L, int tid, int lane, int wid) {
    LAS float* kfs = (LAS float*)(lds + HY_KFS) + 16; LAS float* red = (LAS float*)(lds + HY_RED);
    float s = 0.f;
#pragma unroll
    for (int j = 0; j < 8; ++j) { const int i = tid + NTHR * j; if (i < 2 * L) { const float kv = (i >= 1) ? kf[j] : 0.f; kfs[i] = kv; s += fabsf(kv); } }
    if (tid < 24) kfs[tid < 16 ? tid - 16 : 2 * L + tid - 16] = 0.f;
    s = wave_sum(s);
    if (lane == 0) red[wid] = s;
    __syncthreads();
    float tot = 0.f;
#pragma unroll
    for (int i = 0; i < 8; ++i) tot += red[i];
    const int ny8 = (2 * L + 16) >> 3;
    for (int e = tid; e < ny8; e += NTHR) {
        const int y0 = e * 8;
        float w[16];
#pragma unroll
        for (int k4 = 0; k4 < 16; k4 += 4) *(f32x4*)(w + k4) = *(const LAS f32x4*)(kfs + 2 * L - y0 - 8 + k4);
#pragma unroll
        for (int rho = 0; rho < 8; ++rho) {
            u32x4 o; o.x = pkbf(w[rho + 8], w[rho + 7]); o.y = pkbf(w[rho + 6], w[rho + 5]); o.z = pkbf(w[rho + 4], w[rho + 3]); o.w = pkbf(w[rho + 2], w[rho + 1]);
            *(LAS u32x4*)(lds + HY_FC + rho * HY_FCS + y0 * 2) = o; }
    }
    return 1.f / (tot + EPS);
}
__device__ __forceinline__ f32x16 hy_conv_tile(const LAS unsigned char* lds, int L, int a0, int lane) {
    const int i = lane & 31, h = lane >> 5, q = i >> 2, n = i & 3, nb = L >> 5;
    f32x16 acc = (f32x16){};
    const int dlo = a0 - (nb - 1), dhi = a0 + 7;
    const LAS unsigned char* ap = lds + HY_FC + (i & 7) * HY_FCS + 2 * (L + 8 * h - 8 * (i >> 3) - 32 * dlo);
    const LAS unsigned char* bp = lds + HY_U + n * HY_US + 2 * (224 + 32 * (a0 - dlo + q) + 8 * h);
    f32x16 acc2 = (f32x16){};
    bf16x8 A0 = *(const LAS bf16x8*)ap, A1 = *(const LAS bf16x8*)(ap + 32), B0 = *(const LAS bf16x8*)bp, B1 = *(const LAS bf16x8*)(bp + 32);
    for (int d = dlo; d < dhi; ++d) {
        ap -= 64; bp -= 64;
        const bf16x8 nA0 = *(const LAS bf16x8*)ap, nA1 = *(const LAS bf16x8*)(ap + 32), nB0 = *(const LAS bf16x8*)bp, nB1 = *(const LAS bf16x8*)(bp + 32);
        acc = __builtin_amdgcn_mfma_f32_32x32x16_bf16(A0, B0, acc, 0, 0, 0);
        acc2 = __builtin_amdgcn_mfma_f32_32x32x16_bf16(A1, B1, acc2, 0, 0, 0);
        A0 = nA0; A1 = nA1; B0 = nB0; B1 = nB1;
    }
    acc = __builtin_amdgcn_mfma_f32_32x32x16_bf16(A0, B0, acc, 0, 0, 0);
    acc2 = __builtin_amdgcn_mfma_f32_32x32x16_bf16(A1, B1, acc2, 0, 0, 0);
    return acc + acc2;
}

__device__ __forceinline__ void hyena_compute(LAS unsigned char* lds, PK P, const HyRegs& R, int l, int c, bool isctx) {
    int tid_ = threadIdx.x; asm volatile("" : "+v"(tid_)); const int tid = tid_, lane = tid & 63, wid = rfl(tid >> 6);
    const int L = isctx ? CTX : SEQ, row0 = isctx ? RX : 0, ntile = L >> 8;
    bf16* MIXA = (bf16*)(P->ws + WS_MIXA);
    const float* sw = P->in[I_HYSW] + (size_t)l * 3 * 1536;
    const float bias0 = P->in[I_HBIAS][(size_t)l * 1024 + c], bias1 = P->in[I_HBIAS][(size_t)l * 1024 + 512 + c];
    for (int e = tid; e < 4 * 448 / 8; e += NTHR) { const int n = e / 56, k = e - n * 56; const int off = (k < 28) ? k * 16 : (224 + L) * 2 + (k - 28) * 16;
        *(LAS u32x4*)(lds + HY_U + n * HY_US + off) = (u32x4){0u, 0u, 0u, 0u}; }
    hy_fill_conv3(lds + HY_U, HY_US, 224, R.ch[0], R.hp[0], R.hn[0], L, sw[c], sw[1536 + c], sw[3072 + c], tid);
    hy_fill_conv3(lds + HY_X1, HY_XS, 0, R.ch[1], R.hp[1], R.hn[1], L, sw[512 + c], sw[1536 + 512 + c], sw[3072 + 512 + c], tid);
    hy_fill_conv3(lds + HY_X2, HY_XS, 0, R.ch[2], R.hp[2], R.hn[2], L, sw[1024 + c], sw[1536 + 1024 + c], sw[3072 + 1024 + c], tid);
    const float inv0 = hy_fill_filter(lds, R.k0, L, tid, lane, wid);
    __syncthreads();
    const int a0 = 8 * wid, i32 = lane & 31, h = lane >> 5, q = i32 >> 2, n = i32 & 3;
    const int tb = 32 * (a0 + q) + 4 * h;
    u32x2 zpk[4];
    if (wid < ntile) {
        const f32x16 acc = hy_conv_tile(lds, L, a0, lane);
#pragma unroll
        for (int rr = 0; rr < 4; ++rr) { const int t = tb + 8 * rr;
            const u32x2 uv = *(const LAS u32x2*)(lds + HY_U + n * HY_US + (224 + t) * 2), x1 = *(const LAS u32x2*)(lds + HY_X1 + n * HY_XS + t * 2);
            const float y0 = acc[4 * rr] * inv0 + bflo(uv.x) * bias0, y1 = acc[4 * rr + 1] * inv0 + bfhi(uv.x) * bias0, y2 = acc[4 * rr + 2] * inv0 + bflo(uv.y) * bias0, y3 = acc[4 * rr + 3] * inv0 + bfhi(uv.y) * bias0;
            zpk[rr].x = pkbf(bflo(x1.x) * y0, bfhi(x1.x) * y1); zpk[rr].y = pkbf(bflo(x1.y) * y2, bfhi(x1.y) * y3); }
    }
    __syncthreads();
    if (wid < ntile) {
#pragma unroll
        for (int rr = 0; rr < 4; ++rr) *(LAS u32x2*)(lds + HY_U + n * HY_US + (224 + tb + 8 * rr) * 2) = zpk[rr];
    }
    const float inv1 = hy_fill_filter(lds, R.k1, L, tid, lane, wid);
    __syncthreads();
    if (wid < ntile) {
        const f32x16 acc = hy_conv_tile(lds, L, a0, lane);
        bf16* op = MIXA + (size_t)(row0 + n * L) * DM + 1024 + c;
#pragma unroll
        for (int rr = 0; rr < 4; ++rr) { const int t = tb + 8 * rr;
            const u32x2 x2 = *(const LAS u32x2*)(lds + HY_X2 + n * HY_XS + t * 2);
            const float z0 = bflo(zpk[rr].x), z1 = bfhi(zpk[rr].x), z2 = bflo(zpk[rr].y), z3 = bfhi(zpk[rr].y);
            const float o0 = bflo(x2.x) * (acc[4 * rr] * inv1 + z0 * bias1), o1 = bfhi(x2.x) * (acc[4 * rr + 1] * inv1 + z1 * bias1);
            const float o2 = bflo(x2.y) * (acc[4 * rr + 2] * inv1 + z2 * bias1), o3 = bfhi(x2.y) * (acc[4 * rr + 3] * inv1 + z3 * bias1);
            const unsigned a = pkbf(o0, o1), bq = pkbf(o2, o3);
            op[(size_t)t * DM] = (bf16)(a & 0xffffu); op[(size_t)(t + 1) * DM] = (bf16)(a >> 16); op[(size_t)(t + 2) * DM] = (bf16)(bq & 0xffffu); op[(size_t)(t + 3) * DM] = (bf16)(bq >> 16); }
    }
    __syncthreads();
}
__device__ __forceinline__ void hyena_parts(LAS unsigned char* lds, PK P, int l, int vcu, int G, bool last) {
    int tid_ = threadIdx.x; asm volatile("" : "+v"(tid_)); const int tid = tid_;
    const int ppc = last ? 1 : 2;
    const int nchan = (vcu < 512) ? (512 - vcu + G - 1) / G : 0, np = nchan * ppc;
    if (np == 0) return;
    HyRegs cur, nxt;
    hy_load(cur, P, l, vcu, false, tid);
    for (int p = 0; p < np; ++p) {
        const int c = vcu + G * (p / ppc); const bool isctx = (p % ppc) == 1;
        if (p + 1 < np) hy_load(nxt, P, l, vcu + G * ((p + 1) / ppc), ((p + 1) % ppc) == 1, tid);
        hyena_compute(lds, P, cur, l, c, isctx);
        cur = nxt;
    }
}
__device__ __forceinline__ void pool_unit(PK P, LAS unsigned char* lds, int l, int rb, int g) {
    int tid_ = threadIdx.x; asm volatile("" : "+v"(tid_)); const int tid = tid_, lane = tid & 63, wid = rfl(tid >> 6), tok = lane & 15, kg = lane >> 4;
    const bf16* PL = (const bf16*)(P->ws + WS_PL); bf16* MIXA = (bf16*)(P->ws + WS_MIXA);
    const bf16* PWT = (const bf16*)(P->ws + WS_W + (size_t)l * LW_SIZE + LW_PWT) + (size_t)g * 128 * 128;
    const float* psc = P->in[I_PSCALE] + (size_t)l * PWD + g * 128;
    u32x4 wst[4];
#pragma unroll
    for (int i = 0; i < 4; ++i) wst[i] = *(const u32x4*)(PWT + (size_t)(tid >> 2) * 128 + ((tid & 3) * 4 + i) * 8);
    const int row = rb * 128 + wid * 16 + tok;
    const int sb = (row < RX) ? (row & ~(SEQ - 1)) : (RX + ((row - RX) & ~(CTX - 1))), Ls = (row < RX) ? SEQ : CTX, t = row - sb;
    const int hw = 1 << g;
    const int lo = max(t - hw, 0), hi = min(t + hw, Ls);
    const float invc = 1.f / (float)(hi - lo);
    bf16x8 xf[4];
#pragma unroll
    for (int ks = 0; ks < 4; ++ks) {
        const bf16* cp = PL + (size_t)sb * PWD + g * 128 + 32 * ks + 8 * kg;
        float s[8] = {0.f, 0.f, 0.f, 0.f, 0.f, 0.f, 0.f, 0.f};
        u32x4 c = {0u, 0u, 0u, 0u};
#define PW_LOOP(W) do { u32x4 v_[W]; \
            _Pragma("unroll") for (int q = 0; q < (W); ++q) { const int r_ = t - (W) / 2 + q; const int rc_ = min(max(r_, 0), Ls - 1); v_[q] = *(const u32x4*)(cp + (size_t)rc_ * PWD); } \
            __builtin_amdgcn_sched_barrier(0); \
            _Pragma("unroll") for (int q = 0; q < (W); ++q) { const int r_ = t - (W) / 2 + q; const float f_ = (r_ >= 0 && r_ < Ls) ? 1.f : 0.f; \
                s[0] += f_ * bflo(v_[q].x); s[1] += f_ * bfhi(v_[q].x); s[2] += f_ * bflo(v_[q].y); s[3] += f_ * bfhi(v_[q].y); s[4] += f_ * bflo(v_[q].z); s[5] += f_ * bfhi(v_[q].z); s[6] += f_ * bflo(v_[q].w); s[7] += f_ * bfhi(v_[q].w); } \
            c = v_[(W) / 2]; } while (0)
        if (g == 0) PW_LOOP(2); else if (g == 1) PW_LOOP(4); else if (g == 2) PW_LOOP(8); else PW_LOOP(16);
#undef PW_LOOP
        u32x4 o; o.x = pkbf(s[0] * invc - bflo(c.x), s[1] * invc - bfhi(c.x)); o.y = pkbf(s[2] * invc - bflo(c.y), s[3] * invc - bfhi(c.y));
        o.z = pkbf(s[4] * invc - bflo(c.z), s[5] * invc - bfhi(c.z)); o.w = pkbf(s[6] * invc - bflo(c.w), s[7] * invc - bfhi(c.w));
        xf[ks] = __builtin_bit_cast(bf16x8, o);
    }
#pragma unroll
    for (int i = 0; i < 4; ++i) *(LAS u32x4*)(lds + (tid >> 2) * 272 + ((tid & 3) * 4 + i) * 16) = wst[i];
    __syncthreads();
    f32x4 scv[8];
#pragma unroll
    for (int nbk = 0; nbk < 8; ++nbk) scv[nbk] = *(const f32x4*)(psc + nbk * 16 + 4 * kg);
    __builtin_amdgcn_sched_barrier(0);
#pragma unroll
    for (int nbk = 0; nbk < 8; ++nbk) {
        f32x4 acc = {0.f, 0.f, 0.f, 0.f};
#pragma unroll
        for (int ks = 0; ks < 4; ++ks) { const bf16x8 wf = *(const LAS bf16x8*)(lds + (nbk * 16 + tok) * 272 + (32 * ks + 8 * kg) * 2);
            acc = __builtin_amdgcn_mfma_f32_16x16x32_bf16(wf, xf[ks], acc, 0, 0, 0); }
        const int n0 = nbk * 16 + 4 * kg; const f32x4 sc = scv[nbk];
        u32x2 w; w.x = pkbf(acc[0] * sc.x, acc[1] * sc.y); w.y = pkbf(acc[2] * sc.z, acc[3] * sc.w);
        *(u32x2*)(MIXA + (size_t)row * DM + 1536 + g * 128 + n0) = w;
    }
    __syncthreads();
}

constexpr int NPHASE = 2 + 9 * DEPTH;
constexpr int CV1 = 0, CV2 = 1817, CV3 = 1817, CV4 = 2017;
#ifndef DUPM
#define DUPM 0
#endif
#ifndef DUPB
#define DUPB 0
#endif
__global__ void __launch_bounds__(NTHR, 2) mk_fwd(Params Pv) {
    extern __shared__ __attribute__((aligned(16))) unsigned char lds_raw[];
    LAS unsigned char* lds = (LAS unsigned char*)lds_raw;
    const int G = gridDim.x, bx = blockIdx.x, vcu = (G % 8 == 0) ? (bx % 8) * (G / 8) + bx / 8 : bx;
    const int ph_lo = Pv.ph_lo, ph_hi = Pv.ph_hi;
    if (threadIdx.x < 64) ((LAS unsigned*)(lds + MISC_OFF))[threadIdx.x] = 0u;
    __syncthreads();
    XcdBarrier bar; bar.bar = (unsigned*)(Pv.ws + WS_CTL) + 4096; bar.x = 0; bar.st = nullptr;
    if (ph_hi - ph_lo > 1) bar = xcd_barrier_post((unsigned*)(Pv.ws + WS_CTL) + 4096, (volatile LAS unsigned*)(lds + MISC_OFF) + 8);
#define RUN(p) (ph_lo <= (p) && (p) < ph_hi)
#define SEAM(p) do { if (RUN(p) && RUN((p) + 1)) { xcd_barrier(bar); if (DUPB) xcd_barrier(bar); } } while (0)
#define REP(bit) for (int rep_ = 0; rep_ < (((DUPM) >> (bit)) & 1) + 1; ++rep_)
#define PH_VARS PK P = pk_get(); unsigned char* ws = P->ws; unsigned char* lw = ws + WS_W + (size_t)l * LW_SIZE; const float* ada = (const float*)(ws + WS_ADA) + (size_t)l * 5 * 12288; const float* ng = P->in[I_NORMG] + (size_t)l * 4 * DM; (void)lw; (void)ada; (void)ng

    if (RUN(0)) REP(0) { PK P = pk_get(); prologue_phase(P, lds, vcu, G); __syncthreads(); }
    SEAM(0);
    if (RUN(1)) {
        PK P = pk_get(); const float* ada0 = (const float*)(P->ws + WS_ADA);
        norm_phase<0>(P, vcu, G, RT, ada0, 0, nullptr, nullptr, nullptr, true, ada0, 0, 1, P->in[I_NORMG]);
    }
    SEAM(1);

    for (int l = 0; l < DEPTH; ++l) {
        const int pb = 2 + 9 * l;
        const bool last = (l == DEPTH - 1);
        const int MR = last ? RX : RT;
        if (RUN(pb)) { PH_VARS;
            pg8::Gemm g{(const pg8::bf16_t*)(ws + WS_H), (const pg8::bf16_t*)(lw + LW_WIN), MR, INW, DM, DM, DM};
            OrderX S; S.base.init(MR, INW, G, bx); S.extra = last ? 32 : 0;
            EpiG1 E{(bf16*)(ws + WS_QKV), (bf16*)(ws + WS_HYT), (bf16*)(ws + WS_PL), (bf16*)(ws + WS_GT), (const float*)(ws + WS_ROPE), (const float*)(ws + WS_ROPE) + 1024};
            REP(1) pg8::gemm_phase<EpiG1, OrderX, true, true>(lds, g, S, E);
            if (!last) { const int r = S.base.nwg % G; if (bx >= r) { ada_items(P, lds, l + 1, bx - r, G - r); conv_items(P, lds, l + 1, 0, CV1, bx - r, G - r); } }
        }
        SEAM(pb);
        if (RUN(pb + 1)) { PH_VARS;
            const float* sc = (const float*)(ws + WS_SC) + 2 * l;
            const float lam = sc[0], oscale = sc[1];
            const float* subg = P->in[I_SUBG] + (size_t)l * 128;
            REP(2) for (int u = vcu; u < 512; u += G) attn_unit(lds, (const bf16*)(ws + WS_QKV), (bf16*)(ws + WS_MIXA), lam, oscale, subg, u >> 7, (u >> 4) & 7, u & 15, false);
            REP(3) hyena_parts(lds, P, l, vcu, G, last);
            REP(2) if (!last) for (int u = vcu; u < 64; u += G) attn_unit(lds, (const bf16*)(ws + WS_QKV), (bf16*)(ws + WS_MIXA), lam, oscale, subg, u >> 4, (u >> 1) & 7, u & 1, true);
            const int npool = (MR >> 7) * 4;
            REP(4) for (int u = (vcu + G - 64 % G) % G; u < npool; u += G) pool_unit(P, lds, l, u >> 2, u & 3);
            if (!last) conv_items(P, lds, l + 1, CV4, CONV_ALL, vcu, G);
        }
        SEAM(pb + 1);
        if (RUN(pb + 2)) { PH_VARS; REP(5) {
            pg8::Gemm g{(const pg8::bf16_t*)(ws + WS_MIXA), (const pg8::bf16_t*)(lw + LW_WAO), MR, DM, 512, DM, DM};
            OrderG2 S; S.ctx2 = !last && G == 256; S.base.init(S.ctx2 ? RX : MR, DM, G, bx); if (S.ctx2) S.init2();
            EpiG2 E{(const bf16*)(ws + WS_GT), (bf16*)(ws + WS_MERGED)};
            pg8::gemm_phase<EpiG2, OrderG2, true, true>(lds, g, S, E);
            if (!last) {
                if (S.ctx2) { const int wg = (S.pm0 >> 3) * 64 + S.pn0 * 8 + (S.pm0 & 7);
                    if (S.pm1 < 0) conv_items(P, lds, l + 1, CV1, CV2, wg - (wg >> 3) - 1, 224); }
                else { const int r = S.base.nwg % G; if (bx >= r) conv_items(P, lds, l + 1, CV1, CV2, bx - r, G - r); }
            }
        } }
        SEAM(pb + 2);
        if (RUN(pb + 3)) { PH_VARS; REP(6) {
            pg8::Gemm g{(const pg8::bf16_t*)(ws + WS_MERGED), (const pg8::bf16_t*)(lw + LW_WOUT), RX, DM, DM, DM, DM};
            OrderLatCtx S; S.init(RX, DM, G, bx); S.ctx = !last; S.sp = SplitOrder{128, 4, 512, G, (bx + G / 2) % G};
            EpiPlainSlab E{EpiPlain{(bf16*)(ws + WS_MIX), DM}, EpiSlab{(float*)(ws + WS_SLAB)}};
            pg8::gemm_phase<EpiPlainSlab, OrderLatCtx, true, true>(lds, g, S, E);
        } }
        SEAM(pb + 3);
        if (RUN(pb + 4)) { PH_VARS; norm_phase<1>(P, vcu, G, MR, ada, 2, ng + DM, (const bf16*)(ws + WS_MIX), nullptr, true, ada, 3, 4, ng + 2 * DM, (const float*)(ws + WS_SLAB), last ? 0 : 4); }
        SEAM(pb + 4);
        if (RUN(pb + 5)) { PH_VARS;
            pg8::Gemm g{(const pg8::bf16_t*)(ws + WS_H), (const pg8::bf16_t*)(lw + LW_WUP), MR, INW, DM, DM, DM};
            OrderX S; S.base.init(MR, INW, G, bx); S.extra = 0;
            EpiG4F E{(bf16*)(ws + WS_ACT), (bf16*)(ws + WS_EG), (bf16*)(ws + WS_EV), P->in[I_FFCW] + (size_t)l * 3 * FF};
            REP(7) pg8::gemm_phase<EpiG4F, OrderX, true, true>(lds, g, S, E);
            if (!last) { const int r = S.base.nwg % G; if (bx >= r) { filter_items(P, lds, l + 1, bx - r, G - r); conv_items(P, lds, l + 1, CV2, CV3, bx - r, G - r); } }
        }
        SEAM(pb + 5);
        if (RUN(pb + 6)) REP(8) { PH_VARS; act_edge_phase(P, vcu, G, MR, P->in[I_FFCW] + (size_t)l * 3 * FF); }
        SEAM(pb + 6);
        if (RUN(pb + 7)) { PH_VARS; REP(9) {
            pg8::Gemm g{(const pg8::bf16_t*)(ws + WS_ACT), (const pg8::bf16_t*)(lw + LW_WDN), RX, DM, FF, FF, FF};
            OrderLatCtx S; S.init(RX, DM, G, bx); S.ctx = !last; S.sp = SplitOrder{128, 4, 1408, G, bx};
            EpiPlainSlab E{EpiPlain{(bf16*)(ws + WS_MIX), DM}, EpiSlab{(float*)(ws + WS_SLAB)}};
            pg8::gemm_phase<EpiPlainSlab, OrderLatCtx, true, true>(lds, g, S, E);
            if (!last && bx >= 128) conv_items(P, lds, l + 1, CV3, CV4, bx - 128, G - 128);
        } }
        SEAM(pb + 7);
        if (RUN(pb + 8)) { PH_VARS;
            if (!last) norm_phase<1>(P, vcu, G, RT, ada, 5, ng + 3 * DM, (const bf16*)(ws + WS_MIX), nullptr, true, ada + 5 * 12288, 0, 1, ng + 4 * DM, (const float*)(ws + WS_SLAB), 4);
            else norm_phase<1>(P, vcu, G, RX, ada, 5, ng + 3 * DM, (const bf16*)(ws + WS_MIX), P->out, false, ada, 0, 1, ng);
        }
        if (!last) SEAM(pb + 8);
    }
#undef RUN
#undef SEAM
#undef REP
#undef PH_VARS
}

extern "C" void kernel_launch(void* const* d_in, const int* in_sizes, int n_in, void* d_out, int out_size, void* d_ws, size_t ws_size, hipStream_t stream) {
    static int grid = 0;
    if (grid == 0) {
        if (n_in != 27 || out_size != RX * DM || ws_size < WS_END) { fprintf(stderr, "kernel_launch: unexpected problem shape (n_in %d, out %d, ws %zu < %zu)\n", n_in, out_size, ws_size, (size_t)WS_END); grid = -1; return; }
        int dev = 0, cus = 0;
        if (hipGetDevice(&dev) != hipSuccess || hipDeviceGetAttribute(&cus, hipDeviceAttributeMultiprocessorCount, dev) != hipSuccess || cus <= 0) { grid = -1; return; }
        if (hipFuncSetAttribute((const void*)mk_fwd, hipFuncAttributeMaxDynamicSharedMemorySize, LDS_BYTES) != hipSuccess) { fprintf(stderr, "kernel_launch: hipFuncSetAttribute failed\n"); grid = -1; return; }
        int per_cu = 0;
        if (hipOccupancyMaxActiveBlocksPerMultiprocessor(&per_cu, (const void*)mk_fwd, NTHR, LDS_BYTES) != hipSuccess || per_cu < 1) fprintf(stderr, "kernel_launch: occupancy query reports %d blocks per CU\n", per_cu);
        (void)hipGetLastError();
        grid = cus;
    }
    if (grid < 0) return;
    if (hipMemsetAsync((char*)d_ws + WS_CTL, 0, CTL_ZERO, stream) != hipSuccess) return;
    Params p{};
    for (int i = 0; i < 27; ++i) p.in[i] = (const float*)d_in[i];
    p.out = (float*)d_out; p.ws = (unsigned char*)d_ws;
    p.ph_lo = 0; p.ph_hi = NPHASE;
    hipLaunchKernelGGL(mk_fwd, dim3(grid), dim3(NTHR), LDS_BYTES, stream, p);
}
```

```cpp
#include <hip/hip_runtime.h>
#include <cstdio>
#include <cstdint>
#define GAS __attribute__((address_space(1)))
#define LAS __attribute__((address_space(3)))
typedef unsigned short bf16;
typedef float f32x4 __attribute__((ext_vector_type(4)));
typedef float f32x2 __attribute__((ext_vector_type(2)));
typedef float f32x16 __attribute__((ext_vector_type(16)));
typedef unsigned u32x4 __attribute__((ext_vector_type(4)));
typedef unsigned u32x2 __attribute__((ext_vector_type(2)));
typedef short bf16x8 __attribute__((ext_vector_type(8)));
typedef short s16x4 __attribute__((ext_vector_type(4)));
typedef __bf16 bf16x2_t __attribute__((ext_vector_type(2)));

constexpr int DM = 2048, NBATCH = 4, SEQ = 2048, DEPTH = 4, CTX = 256;
constexpr int RX = NBATCH * SEQ, RC = NBATCH * CTX, RT = RX + RC;
constexpr int INW = 11264, FF = 5632, AW = 1024, HWD = 512, PWD = 512;
constexpr int NQKV = 3072, NGT = 6144;
constexpr float EPS = 1e-6f;
constexpr float QSCALE = 0.125f * 1.4426950408889634f;
constexpr int NWAVES = 8, NTHR = 512;

constexpr size_t al256(size_t x) { return (x + 255) & ~(size_t)255; }
constexpr size_t WS_CTL = 0, CTL_BYTES = 1u << 20, CTL_ZERO = 64u << 10;
constexpr size_t SZ_WIN = (size_t)INW * DM * 2, SZ_WUP = SZ_WIN, SZ_WDN = (size_t)DM * FF * 2, SZ_WOUT = (size_t)DM * DM * 2;
constexpr size_t SZ_WAO = (size_t)DM * AW * 2, SZ_WHO = (size_t)DM * HWD * 2, SZ_WPO = (size_t)DM * PWD * 2, SZ_PWT = 4 * 128 * 128 * 2;
constexpr size_t LW_WIN = 0, LW_WUP = LW_WIN + SZ_WIN, LW_WDN = LW_WUP + SZ_WUP, LW_WOUT = LW_WDN + SZ_WDN, LW_WAO = LW_WOUT + SZ_WOUT,
                 LW_WHO = LW_WAO + SZ_WAO, LW_WPO = LW_WHO + SZ_WHO, LW_PWT = LW_WPO + SZ_WPO, LW_SIZE = LW_PWT + SZ_PWT;
constexpr size_t WS_W = CTL_BYTES;
constexpr size_t WS_ADA = WS_W + DEPTH * LW_SIZE;
constexpr size_t WS_KF = al256(WS_ADA + (size_t)DEPTH * 5 * 12288 * 4);
constexpr size_t WS_KFC = WS_KF + (size_t)DEPTH * 2 * 512 * 4096 * 4;
constexpr size_t WS_ROPE = WS_KFC + (size_t)DEPTH * 2 * 512 * 512 * 4;
constexpr size_t WS_SC = WS_ROPE + 8192;
constexpr size_t WS_XRES = al256(WS_SC + 256);
constexpr size_t WS_H = WS_XRES + (size_t)RT * DM * 4;
constexpr size_t WS_QKV = WS_H + (size_t)RT * DM * 2;
constexpr size_t WS_HYT = WS_QKV + (size_t)RT * NQKV * 2;
constexpr size_t WS_PL = WS_HYT + (size_t)1536 * RT * 2;
constexpr size_t WS_GT = WS_PL + (size_t)RT * 512 * 2;
constexpr size_t WS_UP = WS_QKV;
constexpr size_t WS_EG = WS_UP;
constexpr size_t WS_EV = WS_EG + (size_t)144 * 4 * FF * 2;
constexpr size_t WS_MIXA = WS_GT + (size_t)RT * NGT * 2;
constexpr size_t WS_M32 = WS_MIXA + (size_t)RT * DM * 2;
constexpr size_t WS_MERGED = WS_M32 + (size_t)RT * DM * 4;
constexpr size_t WS_ACT = WS_M32;
constexpr size_t WS_MIX = WS_MERGED + (size_t)RT * DM * 2;
constexpr size_t WS_SLAB = WS_MIX + (size_t)RT * DM * 2;
constexpr size_t WS_END = WS_SLAB + (size_t)8 * RC * DM * 4;
static_assert(WS_UP + (size_t)RT * INW * 2 <= WS_MIXA, "UP overlay");
static_assert(WS_ACT + (size_t)RT * FF * 2 <= WS_MIX, "ACT overlay");

constexpr int MISC_OFF = 147456, LDS_BYTES = MISC_OFF + 256;

__device__ __forceinline__ int rfl(int v) { return __builtin_amdgcn_readfirstlane(v); }
__device__ __forceinline__ unsigned pkbf(float lo, float hi) { f32x2 v = {lo, hi}; bf16x2_t b = __builtin_convertvector(v, bf16x2_t); return __builtin_bit_cast(unsigned, b); }
__device__ __forceinline__ float bflo(unsigned u) { return __uint_as_float(u << 16); }
__device__ __forceinline__ float bfhi(unsigned u) { return __uint_as_float(u & 0xffff0000u); }
__device__ __forceinline__ float wave_sum(float v) {
#pragma unroll
    for (int o = 1; o < 64; o <<= 1) v += __shfl_xor(v, o);
    return v;
}
__device__ __forceinline__ float xhalf_max(float m) { auto rr = __builtin_amdgcn_permlane32_swap(__float_as_uint(m), __float_as_uint(m), false, false); return fmaxf(__uint_as_float(rr[0]), __uint_as_float(rr[1])); }
__device__ __forceinline__ float xhalf_sum(float m) { auto rr = __builtin_amdgcn_permlane32_swap(__float_as_uint(m), __float_as_uint(m), false, false); return __uint_as_float(rr[0]) + __uint_as_float(rr[1]); }
#define LDS_WAIT() asm volatile("s_waitcnt lgkmcnt(0)" ::: "memory")
__device__ __forceinline__ float max3f(float a, float b, float c) { float r; asm("v_max3_f32 %0, %1, %2, %3" : "=v"(r) : "v"(a), "v"(b), "v"(c)); return r; }

struct Params { const float* in[27]; float* out; unsigned char* ws; int ph_lo, ph_hi; };
typedef const __attribute__((address_space(4))) Params* PK;
__device__ __forceinline__ PK pk_get() { PK p = (PK)__builtin_amdgcn_kernarg_segment_ptr(); asm volatile("" : "+s"(p)); return p; }
enum { I_X = 0, I_C, I_CTX, I_CCTX, I_WADA, I_BADA, I_NORMG, I_WIN, I_DLAM, I_SUBG, I_HYSW, I_HW1, I_HB1, I_HW2, I_HB2, I_HW3, I_HFREQ, I_HBIAS,
       I_POOLW, I_PSCALE, I_WAO, I_WHO, I_WPO, I_WOUT, I_WUP, I_FFCW, I_WDN };
namespace pg8 {
#define PG8_LAS __attribute__((address_space(3)))
typedef unsigned short bf16_t;
typedef short bf16x8 __attribute__((ext_vector_type(8)));
typedef float f32x4 __attribute__((ext_vector_type(4)));
typedef unsigned u32x4 __attribute__((ext_vector_type(4)));
constexpr int BM = 256, BK = 64, HALF = 128, HTB = HALF * BK * 2  , STAGE_BYTES = 8 * HTB, NXCD = 8, WGM = 8;

__host__ __device__ __forceinline__ int lds_byte(int r, int c) { const int st = (r >> 4) * 2 + (c >> 5), rr = r & 15, cc = c & 31, ob = rr * 64 + cc * 2; return st * 1024 + (ob ^ (((ob >> 9) & 1) << 5)); }
__host__ __device__ __forceinline__ void stage_rc(int b, int& R, int& C) { const int st = b / 1024, sb = b % 1024, swz = sb ^ (((sb >> 9) & 1) << 5); R = (st >> 1) * 16 + swz / 64; C = (st & 1) * 32 + (swz % 64) / 2; }
__host__ __device__ __forceinline__ int perm32(int rho) { const int n = rho >> 4, i = rho & 15; return 8 * (i >> 2) + 4 * n + (i & 3); }

struct Unit { int pm, pn, ko, ks, kt; };
struct Gemm { const bf16_t* A; const bf16_t* Bt; int M, N, K, lda, ldb; };

struct StaticOrder {
    int nM, nN, nwg, G, c;
    __host__ __device__ void init(int M, int N, int G_, int c_) { nM = M / BM; nN = N / BM; nwg = nM * nN; G = G_; c = c_; }
    __host__ __device__ bool next(int i, Unit& u) const {
        const long L = (long)i * G + c; if (L >= nwg) return false;
        int wgid = (int)L; { const int q = nwg / NXCD, r = nwg % NXCD, xcd = wgid % NXCD, off = wgid / NXCD; wgid = (xcd < r ? xcd * (q + 1) : r * (q + 1) + (xcd - r) * q) + off; }
        const int nig = WGM * nN, gid = wgid / nig, fm = gid * WGM, gsz = (nM - fm) < WGM ? (nM - fm) : WGM;
        u.pm = fm + ((wgid % nig) % gsz); u.pn = (wgid % nig) / gsz; u.ko = 0; u.ks = 0; u.kt = 0; return true;
    }
    __device__ __forceinline__ void a_ready(const Unit&) const {}
    __device__ __forceinline__ void done(const Unit&) const {}
};
__device__ __forceinline__ unsigned cvt_pk_bf16(float lo, float hi) { unsigned r; asm volatile("v_cvt_pk_bf16_f32 %0, %1, %2" : "=v"(r) : "v"(lo), "v"(hi)); return r; }
template <class Epi, class Sched, bool ALIGN_EPI = false, bool SP2 = false>
__device__ __forceinline__ void gemm_phase(PG8_LAS unsigned char* lds, const Gemm g, const Sched& S, const Epi& E) {
    int tid_ = threadIdx.x; asm volatile("" : "+v"(tid_));
    const int tid = tid_, wid = __builtin_amdgcn_readfirstlane(tid >> 6), lane = tid & 63, wr = wid >> 2, wc = wid & 3, fr = lane & 15, fq = lane >> 4;
    const int ntdef = g.K / BK;
    unsigned voffA[2], voffB[2];
#pragma unroll
    for (int i = 0; i < 2; ++i) { int R, C; stage_rc(tid * 16 + i * 8192, R, C); const int Rb = Epi::PERM ? ((R & ~31) + perm32(R & 31)) : R;
        voffA[i] = (unsigned)(R * g.lda + C) * 2u; voffB[i] = (unsigned)(Rb * g.ldb + C) * 2u; }
    const size_t kstep = (size_t)(BK * 2);
    const size_t hstepA = (size_t)HALF * g.lda * 2, hstepB = (size_t)HALF * g.ldb * 2;
    const size_t tstepA = 2 * hstepA, tstepB = 2 * hstepB;
    const unsigned ldsw = (unsigned)wid * 1024u;
    const int aoff = lds_byte(wr * 64 + fr, fq * 8), boff = lds_byte(wc * 32 + fr, fq * 8);
#define PG8_SA(b, h) (((b) * 2 + (h)) * HTB)
#define PG8_SB(b, h) ((4 + (b) * 2 + (h)) * HTB)
#define PG8_STAGE(bufoff, gbase, voff) do { _Pragma("unroll") for (int _i = 0; _i < 2; ++_i) \
        __builtin_amdgcn_global_load_lds((const unsigned*)((const char*)(gbase) + (voff)[_i]), (PG8_LAS unsigned*)(lds + (bufoff) + ldsw + _i * 8192), 16, 0, 0); } while (0)
#define PG8_LDA(dst, b, h) do { _Pragma("unroll") for (int m = 0; m < 4; ++m) _Pragma("unroll") for (int k = 0; k < 2; ++k) dst[m][k] = *(const PG8_LAS bf16x8*)(lds + PG8_SA(b, h) + aoff + m * 2048 + k * 1024); } while (0)
#define PG8_LDB(dst, b, h) do { _Pragma("unroll") for (int n = 0; n < 2; ++n) _Pragma("unroll") for (int k = 0; k < 2; ++k) dst[n][k] = *(const PG8_LAS bf16x8*)(lds + PG8_SB(b, h) + boff + n * 2048 + k * 1024); } while (0)
#define PG8_MMA(ai, bj, At, Bt) do { __builtin_amdgcn_s_setprio(1); _Pragma("unroll") for (int m = 0; m < 4; ++m) _Pragma("unroll") for (int n = 0; n < 2; ++n) _Pragma("unroll") for (int k = 0; k < 2; ++k) \
        acc[ai][bj][m][n] = __builtin_amdgcn_mfma_f32_16x16x32_bf16(Bt[n][k], At[m][k], acc[ai][bj][m][n], 0, 0, 0); __builtin_amdgcn_s_setprio(0); } while (0)
#define PG8_WAIT_V(n) asm volatile("s_waitcnt vmcnt(" #n ")" ::: "memory")
#define PG8_WAIT_L(n) asm volatile("s_waitcnt lgkmcnt(" #n ")" ::: "memory")
#define PG8_BAR __builtin_amdgcn_s_barrier()
#define PG8_SCHED __builtin_amdgcn_sched_barrier(0)
    Unit cur, nxt; int ui = 0;
    if (!S.next(0, cur)) return;
    f32x4 acc[2][2][4][2];
#pragma unroll
    for (int a = 0; a < 2; ++a)
#pragma unroll
        for (int b = 0; b < 2; ++b)
#pragma unroll
            for (int m = 0; m < 4; ++m)
#pragma unroll
                for (int n = 0; n < 2; ++n) acc[a][b][m][n] = (f32x4){0.f, 0.f, 0.f, 0.f};
    bf16x8 At[4][2], B0[2][2], B1[2][2];
    const char* cA = (const char*)g.A + (size_t)cur.pm * tstepA + (size_t)cur.ko * 2; const char* cB = (const char*)g.Bt + (size_t)cur.pn * tstepB + (size_t)cur.ko * 2;
    S.a_ready(cur);
    if constexpr (SP2) {
        PG8_STAGE(PG8_SB(0, 0), cB, voffB); PG8_STAGE(PG8_SB(0, 1), cB + hstepB, voffB); PG8_STAGE(PG8_SA(0, 0), cA, voffA); PG8_STAGE(PG8_SA(0, 1), cA + hstepA, voffA);
        if (wr == 1) PG8_BAR;
        PG8_WAIT_V(2); PG8_BAR;
        PG8_STAGE(PG8_SB(1, 0), cB + kstep, voffB); PG8_STAGE(PG8_SA(1, 0), cA + kstep, voffA); PG8_STAGE(PG8_SB(1, 1), cB + hstepB + kstep, voffB);
        PG8_WAIT_V(6); PG8_BAR;
    } else {
        PG8_STAGE(PG8_SB(0, 0), cB, voffB); PG8_STAGE(PG8_SA(0, 0), cA, voffA); PG8_STAGE(PG8_SB(0, 1), cB + hstepB, voffB); PG8_STAGE(PG8_SA(0, 1), cA + hstepA, voffA);
        if (wr == 1) PG8_BAR;
        PG8_WAIT_V(4); PG8_BAR;
        PG8_STAGE(PG8_SB(1, 0), cB + kstep, voffB); PG8_STAGE(PG8_SA(1, 0), cA + kstep, voffA); PG8_STAGE(PG8_SB(1, 1), cB + hstepB + kstep, voffB);
        PG8_WAIT_V(6); PG8_BAR;
    }
    for (;;) {
        const bool has_next = S.next(ui + 1, nxt);
        const char* nA = has_next ? (const char*)g.A + (size_t)nxt.pm * tstepA + (size_t)nxt.ko * 2 : cA; const char* nB = has_next ? (const char*)g.Bt + (size_t)nxt.pn * tstepB + (size_t)nxt.ko * 2 : cB;
        const int nt = cur.kt ? cur.kt : ntdef;
        for (int t = 0; t < nt; t += 2) {
            const bool last = (t == nt - 2);
            const char* a1 = cA + (size_t)(t + 1) * kstep;
            const char* a2 = last ? nA : cA + (size_t)(t + 2) * kstep; const char* b2 = last ? nB : cB + (size_t)(t + 2) * kstep;
            const char* a3 = a2 + kstep; const char* b3 = b2 + kstep;
            if (last && has_next) S.a_ready(nxt);
            if constexpr (SP2) {
            PG8_LDB(B0, 0, 0); PG8_LDB(B1, 0, 1); PG8_SCHED; PG8_LDA(At, 0, 0); PG8_STAGE(PG8_SA(1, 1), a1 + hstepA, voffA);
            PG8_WAIT_V(8); PG8_WAIT_L(0); PG8_BAR; PG8_MMA(0, 0, At, B0); PG8_MMA(0, 1, At, B1); PG8_BAR; PG8_SCHED;
            PG8_LDA(At, 0, 1); PG8_STAGE(PG8_SB(0, 0), b2, voffB); PG8_STAGE(PG8_SB(0, 1), b2 + hstepB, voffB); PG8_STAGE(PG8_SA(0, 0), a2, voffA);
            PG8_WAIT_V(8); PG8_WAIT_L(0); PG8_BAR; PG8_MMA(1, 0, At, B0); PG8_MMA(1, 1, At, B1); PG8_BAR; PG8_SCHED;
            PG8_LDB(B0, 1, 0); PG8_LDB(B1, 1, 1); PG8_SCHED; PG8_LDA(At, 1, 0); PG8_STAGE(PG8_SA(0, 1), a2 + hstepA, voffA);
            PG8_WAIT_V(8); PG8_WAIT_L(0); PG8_BAR; PG8_MMA(0, 0, At, B0); PG8_MMA(0, 1, At, B1); PG8_BAR; PG8_SCHED;
            PG8_LDA(At, 1, 1); PG8_STAGE(PG8_SB(1, 0), b3, voffB); PG8_STAGE(PG8_SB(1, 1), b3 + hstepB, voffB); PG8_STAGE(PG8_SA(1, 0), a3, voffA);
            PG8_WAIT_V(8); PG8_WAIT_L(0); PG8_BAR; PG8_MMA(1, 0, At, B0); PG8_MMA(1, 1, At, B1); PG8_BAR; PG8_SCHED;
            } else {
            PG8_LDB(B0, 0, 0); PG8_SCHED; PG8_LDA(At, 0, 0); PG8_STAGE(PG8_SA(1, 1), a1 + hstepA, voffA);
            PG8_WAIT_L(8); PG8_BAR; PG8_WAIT_L(0); PG8_MMA(0, 0, At, B0); PG8_BAR; PG8_SCHED;
            PG8_LDB(B1, 0, 1); PG8_STAGE(PG8_SB(0, 0), b2, voffB);
            PG8_BAR; PG8_WAIT_L(0); PG8_MMA(0, 1, At, B1); PG8_BAR;
            PG8_LDA(At, 0, 1); PG8_STAGE(PG8_SA(0, 0), a2, voffA);
            PG8_BAR; PG8_WAIT_L(0); PG8_MMA(1, 0, At, B0); PG8_BAR; PG8_SCHED;
            PG8_STAGE(PG8_SB(0, 1), b2 + hstepB, voffB);
            PG8_WAIT_V(6); PG8_BAR; PG8_MMA(1, 1, At, B1); PG8_BAR;
            PG8_LDB(B0, 1, 0); PG8_SCHED; PG8_LDA(At, 1, 0); PG8_STAGE(PG8_SA(0, 1), a2 + hstepA, voffA);
            PG8_WAIT_L(8); PG8_BAR; PG8_WAIT_L(0); PG8_MMA(0, 0, At, B0); PG8_BAR; PG8_SCHED;
            PG8_LDB(B1, 1, 1); PG8_STAGE(PG8_SB(1, 0), b3, voffB);
            PG8_BAR; PG8_WAIT_L(0); PG8_MMA(0, 1, At, B1); PG8_BAR;
            PG8_LDA(At, 1, 1); PG8_STAGE(PG8_SA(1, 0), a3, voffA);
            PG8_BAR; PG8_WAIT_L(0); PG8_MMA(1, 0, At, B0); PG8_BAR; PG8_SCHED;
            PG8_STAGE(PG8_SB(1, 1), b3 + hstepB, voffB);
            PG8_WAIT_V(6); PG8_BAR; PG8_MMA(1, 1, At, B1); PG8_BAR;
            }
        }
        if constexpr (ALIGN_EPI) { if (wr == 0) PG8_BAR; }
        if constexpr (!Epi::AFTER_DRAIN) { E(acc, cur, wr, wc, fr, fq); S.done(cur); }
        if (!has_next) break;
        if (!E.keep(cur)) {
#pragma unroll
        for (int a = 0; a < 2; ++a)
#pragma unroll
            for (int b = 0; b < 2; ++b)
#pragma unroll
                for (int m = 0; m < 4; ++m)
#pragma unroll
                    for (int n = 0; n < 2; ++n) acc[a][b][m][n] = (f32x4){0.f, 0.f, 0.f, 0.f};
        }
        cur = nxt; cA = nA; cB = nB; ++ui;
        if constexpr (ALIGN_EPI) { if (wr == 1) PG8_BAR; }
    }
    PG8_WAIT_V(0);
    if constexpr (!ALIGN_EPI) { if (wr == 0) PG8_BAR; }
    PG8_BAR;
    if constexpr (Epi::AFTER_DRAIN) { E.fused(acc, cur, wr, wc, fr, fq, lds, wid, lane); S.done(cur); }
#undef PG8_SA
#undef PG8_SB
#undef PG8_STAGE
#undef PG8_LDA
#undef PG8_LDB
#undef PG8_MMA
#undef PG8_WAIT_V
#undef PG8_WAIT_L
#undef PG8_BAR
#undef PG8_SCHED
}
}
#define XB_TMO      128
#define XB_XCNT(j)  (256  + 64 * (j))
#define XB_XSUB(j)  (1280 + 64 * (j))
#define XB_XGEN(j)  (2304 + 64 * (j))
#define XB_TOP      3328
#define XB_TOPGEN   3392
#define XCD_BAR_WORDS 3456
#define XB_SPIN_CAP (1u << 18)

__device__ __forceinline__ unsigned xb_ld(unsigned* p)              { return __hip_atomic_load(p, __ATOMIC_RELAXED, __HIP_MEMORY_SCOPE_AGENT); }
__device__ __forceinline__ unsigned xb_add(unsigned* p, unsigned v) { return __hip_atomic_fetch_add(p, v, __ATOMIC_RELAXED, __HIP_MEMORY_SCOPE_AGENT); }
__device__ __forceinline__ unsigned xb_xcc_id() { return (unsigned)__builtin_amdgcn_s_getreg((3 << 11) | 20) & 0xFu; }
#define XB_SPIN(cond, bar) do { unsigned _sp = 0; while (cond) { __builtin_amdgcn_s_sleep(1); \
    if ((++_sp & 255u) == 0u) { if (xb_ld(&(bar)[XB_TMO])) break; if (_sp > XB_SPIN_CAP) { atomicAdd(&(bar)[XB_TMO], 1u); break; } } } } while (0)

struct XcdBarrier {
    unsigned* bar; unsigned x;
    volatile LAS unsigned* st;
};

__device__ __forceinline__ XcdBarrier xcd_barrier_post(unsigned* bar, volatile LAS unsigned* st) {
    XcdBarrier b; b.bar = bar; b.x = xb_xcc_id(); b.st = st;
    if (threadIdx.x == 0) (void)xb_add(&bar[XB_XCNT(b.x)], 1u);
    return b;
}
__device__ __forceinline__ void xcd_barrier_complete(unsigned* bar, unsigned x, unsigned& nloc, unsigned& nx) {
    const unsigned G = gridDim.x * gridDim.y * gridDim.z;
    unsigned sum, cnt, mine, sp = 0u;
    for (;;) {
        sum = 0u; cnt = 0u; mine = 0u;
#pragma unroll
        for (unsigned j = 0; j < 16; ++j) { const unsigned c = xb_ld(&bar[XB_XCNT(j)]); sum += c; cnt += (c > 0u) ? 1u : 0u; mine = (j == x) ? c : mine; }
        if (sum == G) break;
        __builtin_amdgcn_s_sleep(1);
        if ((++sp & 255u) == 0u) { if (xb_ld(&bar[XB_TMO])) break; if (sp > XB_SPIN_CAP) { atomicAdd(&bar[XB_TMO], 1u); break; } }
    }
    nloc = mine > 0u ? mine : 1u; nx = cnt > 0u ? cnt : 1u;
}

__device__ __forceinline__ void xcd_barrier(const XcdBarrier& b) {
    asm volatile("s_waitcnt vmcnt(0)" ::: "memory");
    __syncthreads();
    if (threadIdx.x == 0) {
        unsigned* bar = b.bar;
        __builtin_amdgcn_s_waitcnt(0);
        unsigned nloc = b.st[0], nx = b.st[1];
        if (nloc == 0u) { xcd_barrier_complete(bar, b.x, nloc, nx); b.st[0] = nloc; b.st[1] = nx; }
        const unsigned old = xb_add(&bar[XB_XSUB(b.x)], 1u);
        const unsigned gen = old / nloc;
        if (old + 1u == (gen + 1u) * nloc) {
            __builtin_amdgcn_fence(__ATOMIC_RELEASE, "agent");
            asm volatile("s_waitcnt vmcnt(0)" ::: "memory");
            const unsigned og = xb_add(&bar[XB_TOP], 1u);
            const unsigned tg = og / nx;
            if (og + 1u == (tg + 1u) * nx) xb_add(&bar[XB_TOPGEN], 1u);
            else XB_SPIN(xb_ld(&bar[XB_TOPGEN]) == tg, bar);
            __builtin_amdgcn_fence(__ATOMIC_ACQUIRE, "agent");
            xb_add(&bar[XB_XGEN(b.x)], 1u);
            asm volatile("s_waitcnt vmcnt(0)" ::: "memory");
        } else {
            XB_SPIN(xb_ld(&bar[XB_XGEN(b.x)]) == gen, bar);
            __builtin_amdgcn_fence(__ATOMIC_ACQUIRE, "agent");
            asm volatile("s_waitcnt vmcnt(0)" ::: "memory");
        }
    }
    __syncthreads();
}
struct OrderX {
    pg8::StaticOrder base; int extra;
    __device__ __forceinline__ bool next(int i, pg8::Unit& u) const {
        long L = (long)i * base.G + base.c;
        if (L < base.nwg) return base.next(i, u);
        L -= base.nwg; if (L >= extra) return false;
        u.pm = 32 + (int)(L >> 3); u.pn = 4 + (int)(L & 7); u.ko = 0; u.ks = 0; u.kt = 0; return true;
    }
    __device__ __forceinline__ void a_ready(const pg8::Unit&) const {}
    __device__ __forceinline__ void done(const pg8::Unit&) const {}
};

struct EpiPlain {
    static constexpr bool PERM = true, AFTER_DRAIN = false; __device__ __forceinline__ bool keep(const pg8::Unit&) const { return false; }
    bf16* O; int ldc;
    __device__ __forceinline__ void operator()(const f32x4 (&acc)[2][2][4][2], const pg8::Unit& u, int wr, int wc, int fr, int fq) const {
        const int row0 = u.pm * 256 + wr * 64 + fr, col0 = u.pn * 256 + wc * 32 + 8 * fq;
#pragma unroll
        for (int ai = 0; ai < 2; ++ai)
#pragma unroll
            for (int m = 0; m < 4; ++m) { bf16* rowp = O + (size_t)(row0 + ai * 128 + m * 16) * ldc + col0;
#pragma unroll
                for (int bj = 0; bj < 2; ++bj) { const f32x4 v0 = acc[ai][bj][m][0], v1 = acc[ai][bj][m][1];
                    u32x4 w; w.x = pkbf(v0[0], v0[1]); w.y = pkbf(v0[2], v0[3]); w.z = pkbf(v1[0], v1[1]); w.w = pkbf(v1[2], v1[3]);
                    *(u32x4*)(rowp + bj * 128) = w; } }
    }
};

struct EpiG1 {
    static constexpr bool PERM = true, AFTER_DRAIN = false; __device__ __forceinline__ bool keep(const pg8::Unit&) const { return false; }
    bf16* QKV; bf16* HYT; bf16* PL; bf16* GT; const float* ropeC; const float* ropeS;
    __device__ __forceinline__ void operator()(const f32x4 (&acc)[2][2][4][2], const pg8::Unit& u, int wr, int wc, int fr, int fq) const {
        const int pn = u.pn, pm = u.pm;
        const int row0 = pm * 256 + wr * 64 + fr;
        if (pn < 12) {
            const bool rope = (pn < 8) && (pm < 32);
            const float sc = (pn < 4) ? QSCALE : 1.f;
            const int col0 = pn * 256 + wc * 32 + 8 * fq;
#pragma unroll
            for (int ai = 0; ai < 2; ++ai) {
                f32x4 csv[4], snv[4];
#pragma unroll
                for (int m = 0; m < 4; ++m) { csv[m] = (f32x4){1.f, 1.f, 1.f, 1.f}; snv[m] = (f32x4){0.f, 0.f, 0.f, 0.f};
                    if (rope) { const int t = (row0 + ai * 128 + m * 16) & (SEQ - 1); const int pos = (wc & 1) ? (t & 63) : (t >> 6);
                        csv[m] = *(const f32x4*)(ropeC + pos * 16 + 4 * fq); snv[m] = *(const f32x4*)(ropeS + pos * 16 + 4 * fq); } }
                __builtin_amdgcn_sched_barrier(0);
#pragma unroll
                for (int m = 0; m < 4; ++m) {
                    const int row = row0 + ai * 128 + m * 16;
                    const f32x4 cs = csv[m], sn = snv[m];
                    bf16* rowp = QKV + (size_t)row * NQKV + col0;
#pragma unroll
                    for (int bj = 0; bj < 2; ++bj) { const f32x4 v0 = acc[ai][bj][m][0], v1 = acc[ai][bj][m][1];
                        float o0 = v0[0] * cs[0] - v0[1] * sn[0], o1 = v0[1] * cs[0] + v0[0] * sn[0];
                        float o2 = v0[2] * cs[1] - v0[3] * sn[1], o3 = v0[3] * cs[1] + v0[2] * sn[1];
                        float o4 = v1[0] * cs[2] - v1[1] * sn[2], o5 = v1[1] * cs[2] + v1[0] * sn[2];
                        float o6 = v1[2] * cs[3] - v1[3] * sn[3], o7 = v1[3] * cs[3] + v1[2] * sn[3];
                        u32x4 w; w.x = pkbf(o0 * sc, o1 * sc); w.y = pkbf(o2 * sc, o3 * sc); w.z = pkbf(o4 * sc, o5 * sc); w.w = pkbf(o6 * sc, o7 * sc);
                        *(u32x4*)(rowp + bj * 128) = w; }
                }
            }
        } else if (pn < 18) {
            const int ch0 = (pn - 12) * 256 + wc * 32 + 8 * fq;
            const int odd = fr & 1;
#pragma unroll
            for (int ai = 0; ai < 2; ++ai)
#pragma unroll
                for (int m = 0; m < 4; ++m) {
                    const int row = row0 + ai * 128 + m * 16;
#pragma unroll
                    for (int bj = 0; bj < 2; ++bj) { const f32x4 v0 = acc[ai][bj][m][0], v1 = acc[ai][bj][m][1];
                        unsigned pk[4] = {pkbf(v0[0], v0[1]), pkbf(v0[2], v0[3]), pkbf(v1[0], v1[1]), pkbf(v1[2], v1[3])};
#pragma unroll
                        for (int j = 0; j < 4; ++j) { const unsigned nb = (unsigned)__shfl_xor((int)pk[j], 1);
                            const unsigned o = odd ? ((nb >> 16) | (pk[j] & 0xffff0000u)) : ((pk[j] & 0xffffu) | (nb << 16));
                            const int ch = ch0 + bj * 128 + 2 * j + odd;
                            *(unsigned*)(HYT + (size_t)ch * RT + (row - odd)) = o; }
                    }
                }
        } else if (pn < 20) {
            const int col0 = (pn - 18) * 256 + wc * 32 + 8 * fq;
#pragma unroll
            for (int ai = 0; ai < 2; ++ai)
#pragma unroll
                for (int m = 0; m < 4; ++m) { bf16* rowp = PL + (size_t)(row0 + ai * 128 + m * 16) * PWD + col0;
#pragma unroll
                    for (int bj = 0; bj < 2; ++bj) { const f32x4 v0 = acc[ai][bj][m][0], v1 = acc[ai][bj][m][1];
                        u32x4 w; w.x = pkbf(v0[0], v0[1]); w.y = pkbf(v0[2], v0[3]); w.z = pkbf(v1[0], v1[1]); w.w = pkbf(v1[2], v1[3]);
                        *(u32x4*)(rowp + bj * 128) = w; } }
        } else {
            const int col0 = (pn - 20) * 256 + wc * 32 + 8 * fq;
#pragma unroll
            for (int ai = 0; ai < 2; ++ai)
#pragma unroll
                for (int m = 0; m < 4; ++m) { bf16* rowp = GT + (size_t)(row0 + ai * 128 + m * 16) * NGT + col0;
#pragma unroll
                    for (int bj = 0; bj < 2; ++bj) { const f32x4 v0 = acc[ai][bj][m][0], v1 = acc[ai][bj][m][1];
                        float s[8];
#pragma unroll
                        for (int i = 0; i < 4; ++i) { s[i] = __builtin_amdgcn_rcpf(1.f + __builtin_amdgcn_exp2f(-1.4426950408889634f * v0[i])); s[4 + i] = __builtin_amdgcn_rcpf(1.f + __builtin_amdgcn_exp2f(-1.4426950408889634f * v1[i])); }
                        u32x4 w; w.x = pkbf(s[0], s[1]); w.y = pkbf(s[2], s[3]); w.z = pkbf(s[4], s[5]); w.w = pkbf(s[6], s[7]);
                        *(u32x4*)(rowp + bj * 128) = w; } }
        }
    }
};

struct EpiG2 {
    static constexpr bool PERM = true, AFTER_DRAIN = false;
    const bf16* GT; bf16* MERGED;
    __device__ __forceinline__ bool keep(const pg8::Unit& u) const { return u.ks < 3; }
    __device__ __forceinline__ void operator()(f32x4 (&acc)[2][2][4][2], const pg8::Unit& u, int wr, int wc, int fr, int fq) const {
        if (u.ks == 0) return;
        const int seg = u.ks - 1;
        int lane_; asm volatile("v_mbcnt_lo_u32_b32 %0, -1, 0\n\tv_mbcnt_hi_u32_b32 %0, -1, %0" : "=v"(lane_));
        const int fr_ = lane_ & 15, fq_ = lane_ >> 4; (void)fr; (void)fq;
        const int row0 = u.pm * 256 + wr * 64 + fr_, col0 = u.pn * 256 + wc * 32 + 8 * fq_;
        const float eps = 1e-30f;
        if (seg < 2) {
#pragma unroll
            for (int h = 0; h < 4; ++h) { const int ai = h >> 1, bj = h & 1; const int col = col0 + bj * 128;
                u32x4 gn[4], gd[4];
#pragma unroll
                for (int m = 0; m < 4; ++m) { const size_t row = (size_t)(row0 + ai * 128 + m * 16);
                    gn[m] = *(const u32x4*)(GT + row * NGT + seg * DM + col); gd[m] = *(const u32x4*)(GT + row * NGT + (seg + 1) * DM + col); }
                __builtin_amdgcn_sched_barrier(0);
#pragma unroll
                for (int m = 0; m < 4; ++m) {
                    f32x4 f0 = {fmaxf(bflo(gn[m].x), eps) * __builtin_amdgcn_rcpf(fmaxf(bflo(gd[m].x), eps)), fmaxf(bfhi(gn[m].x), eps) * __builtin_amdgcn_rcpf(fmaxf(bfhi(gd[m].x), eps)),
                                fmaxf(bflo(gn[m].y), eps) * __builtin_amdgcn_rcpf(fmaxf(bflo(gd[m].y), eps)), fmaxf(bfhi(gn[m].y), eps) * __builtin_amdgcn_rcpf(fmaxf(bfhi(gd[m].y), eps))};
                    f32x4 f1 = {fmaxf(bflo(gn[m].z), eps) * __builtin_amdgcn_rcpf(fmaxf(bflo(gd[m].z), eps)), fmaxf(bfhi(gn[m].z), eps) * __builtin_amdgcn_rcpf(fmaxf(bfhi(gd[m].z), eps)),
                                fmaxf(bflo(gn[m].w), eps) * __builtin_amdgcn_rcpf(fmaxf(bflo(gd[m].w), eps)), fmaxf(bfhi(gn[m].w), eps) * __builtin_amdgcn_rcpf(fmaxf(bfhi(gd[m].w), eps))};
                    acc[ai][bj][m][0] *= f0; acc[ai][bj][m][1] *= f1; }
                __builtin_amdgcn_sched_barrier(0);
            }
        } else {
#pragma unroll
            for (int h = 0; h < 4; ++h) { const int ai = h >> 1, bj = h & 1; const int col = col0 + bj * 128;
                u32x4 gn[4];
#pragma unroll
                for (int m = 0; m < 4; ++m) { const size_t row = (size_t)(row0 + ai * 128 + m * 16); gn[m] = *(const u32x4*)(GT + row * NGT + 2 * DM + col); }
                __builtin_amdgcn_sched_barrier(0);
#pragma unroll
                for (int m = 0; m < 4; ++m) { const size_t row = (size_t)(row0 + ai * 128 + m * 16);
                    const f32x4 v0 = acc[ai][bj][m][0], v1 = acc[ai][bj][m][1];
                    f32x4 a0 = {v0[0] * fmaxf(bflo(gn[m].x), eps), v0[1] * fmaxf(bfhi(gn[m].x), eps), v0[2] * fmaxf(bflo(gn[m].y), eps), v0[3] * fmaxf(bfhi(gn[m].y), eps)};
                    f32x4 a1 = {v1[0] * fmaxf(bflo(gn[m].z), eps), v1[1] * fmaxf(bfhi(gn[m].z), eps), v1[2] * fmaxf(bflo(gn[m].w), eps), v1[3] * fmaxf(bfhi(gn[m].w), eps)};
                    u32x4 w; w.x = pkbf(a0[0], a0[1]); w.y = pkbf(a0[2], a0[3]); w.z = pkbf(a1[0], a1[1]); w.w = pkbf(a1[2], a1[3]);
                    *(u32x4*)(MERGED + row * DM + col) = w; }
                __builtin_amdgcn_sched_barrier(0);
            }
        }
    }
};
struct OrderG2 {
    pg8::StaticOrder base; bool ctx2 = false; int pm0 = 0, pn0 = 0, pm1 = -1;
    __device__ __forceinline__ void init2() { pg8::Unit f; base.next(0, f); pm0 = f.pm; pn0 = f.pn; pm1 = (f.pm & 7) ? -1 : 32 + (f.pm >> 3); }
    __device__ __forceinline__ bool next(int i, pg8::Unit& u) const {
        const int t = i >> 2;
        if (!ctx2) { if (!base.next(t, u)) return false; }
        else { if (t > 1 || (t == 1 && pm1 < 0)) return false; u.pm = t ? pm1 : pm0; u.pn = pn0; }
        u.ks = i & 3; u.ko = 512 * (i & 3); u.kt = 0; return true; }
    __device__ __forceinline__ void a_ready(const pg8::Unit&) const {}
    __device__ __forceinline__ void done(const pg8::Unit&) const {}
};

struct SplitOrder {
    int nsub, S, kslice, G, c;
    __device__ __forceinline__ bool next(int i, pg8::Unit& u) const {
        const int j = i * G + c; if (j >= nsub) return false;
        const int tile = j / S, ks = j - tile * S; u.pm = 32 + (tile >> 3); u.pn = tile & 7; u.ko = ks * kslice; u.ks = ks; u.kt = kslice >> 6; return true;
    }
    __device__ __forceinline__ void a_ready(const pg8::Unit&) const {}
    __device__ __forceinline__ void done(const pg8::Unit&) const {}
};
struct EpiSlab {
    static constexpr bool PERM = true, AFTER_DRAIN = false; __device__ __forceinline__ bool keep(const pg8::Unit&) const { return false; }
    float* SLAB;
    __device__ __forceinline__ void operator()(const f32x4 (&acc)[2][2][4][2], const pg8::Unit& u, int wr, int wc, int fr, int fq) const {
        const int row0 = (u.pm - 32) * 256 + wr * 64 + fr, col0 = u.pn * 256 + wc * 32 + 8 * fq;
        bf16* base = (bf16*)SLAB + (size_t)u.ks * RC * DM;
#pragma unroll
        for (int ai = 0; ai < 2; ++ai)
#pragma unroll
            for (int m = 0; m < 4; ++m) { bf16* rowp = base + (size_t)(row0 + ai * 128 + m * 16) * DM + col0;
#pragma unroll
                for (int bj = 0; bj < 2; ++bj) { const f32x4 v0 = acc[ai][bj][m][0], v1 = acc[ai][bj][m][1];
                    u32x4 w; w.x = pkbf(v0[0], v0[1]); w.y = pkbf(v0[2], v0[3]); w.z = pkbf(v1[0], v1[1]); w.w = pkbf(v1[2], v1[3]);
                    *(u32x4*)(rowp + bj * 128) = w; } }
    }
};

template <int CTRL> __device__ __forceinline__ float dppf(float x) { return __builtin_bit_cast(float, __builtin_amdgcn_update_dpp(0, __builtin_bit_cast(int, x), CTRL, 0xf, 0xf, true)); }
__device__ __forceinline__ float gelu_tanh_f(float a) { constexpr float GC1 = -2.f * 1.4426950408889634f * 0.7978845608028654f, GC2 = GC1 * 0.044715f;
    const float p = __builtin_fmaf(GC2, a * a, GC1); return a * __builtin_amdgcn_rcpf(1.f + __builtin_amdgcn_exp2f(a * p)); }
struct OrderLatCtx {
    pg8::StaticOrder base; SplitOrder sp; int nlat; bool ctx;
    __device__ __forceinline__ void init(int M, int N, int G, int c) { base.init(M, N, G, c); nlat = c < base.nwg ? (base.nwg - c + G - 1) / G : 0; }
    __device__ __forceinline__ bool next(int i, pg8::Unit& u) const { if (i < nlat) return base.next(i, u); return ctx && sp.next(i - nlat, u); }
    __device__ __forceinline__ void a_ready(const pg8::Unit&) const {}
    __device__ __forceinline__ void done(const pg8::Unit&) const {}
};
struct EpiPlainSlab {
    static constexpr bool PERM = true, AFTER_DRAIN = false; __device__ __forceinline__ bool keep(const pg8::Unit&) const { return false; }
    EpiPlain a; EpiSlab b;
    __device__ __forceinline__ void operator()(const f32x4 (&acc)[2][2][4][2], const pg8::Unit& u, int wr, int wc, int fr, int fq) const { if (u.pm >= 32) b(acc, u, wr, wc, fr, fq); else a(acc, u, wr, wc, fr, fq); }
};
struct EpiG4F {
    static constexpr bool PERM = true, AFTER_DRAIN = false; __device__ __forceinline__ bool keep(const pg8::Unit&) const { return false; }
    bf16* ACT; bf16* EG; bf16* EV; const float* cw;
    __device__ __forceinline__ void operator()(const f32x4 (&acc)[2][2][4][2], const pg8::Unit& u, int wr, int wc, int fr, int fq) const {
        const int ch0 = u.pn * 128 + wc * 32 + 8 * fq;
        float w0[8], w1[8], w2[8];
#pragma unroll
        for (int i = 0; i < 8; i += 4) { *(f32x4*)(w0 + i) = *(const f32x4*)(cw + ch0 + i); *(f32x4*)(w1 + i) = *(const f32x4*)(cw + FF + ch0 + i); *(f32x4*)(w2 + i) = *(const f32x4*)(cw + 2 * FF + ch0 + i); }
#pragma unroll
        for (int ai = 0; ai < 2; ++ai) {
            const int brow = u.pm * 256 + ai * 128 + wr * 64, blk = brow >> 6;
#pragma unroll
            for (int m = 0; m < 4; ++m) {
                const int row = brow + 16 * m + fr;
                float o[8];
#pragma unroll
                for (int e = 0; e < 8; ++e) {
                    const float gc = acc[ai][0][m][e >> 2][e & 3];
                    const float gp = (m > 0) ? acc[ai][0][m > 0 ? m - 1 : 0][e >> 2][e & 3] : gc, gn = (m < 3) ? acc[ai][0][m < 3 ? m + 1 : 3][e >> 2][e & 3] : gc;
                    const float up = dppf<0x121>((fr == 15) ? gp : gc), dn = dppf<0x12F>((fr == 0) ? gn : gc);
                    o[e] = gelu_tanh_f(w0[e] * up + w1[e] * gc + w2[e] * dn) * acc[ai][1][m][e >> 2][e & 3];
                }
                const bool first = (m == 0 && fr == 0), lastr = (m == 3 && fr == 15);
                if (!first && !lastr) { u32x4 w; w.x = pkbf(o[0], o[1]); w.y = pkbf(o[2], o[3]); w.z = pkbf(o[4], o[5]); w.w = pkbf(o[6], o[7]); *(u32x4*)(ACT + (size_t)row * FF + ch0) = w; }
                if ((m == 0 && fr < 2) || (m == 3 && fr > 13)) {
                    const f32x4 g0 = acc[ai][0][m][0], g1 = acc[ai][0][m][1];
                    u32x4 w; w.x = pkbf(g0[0], g0[1]); w.y = pkbf(g0[2], g0[3]); w.z = pkbf(g1[0], g1[1]); w.w = pkbf(g1[2], g1[3]);
                    const int slot = (m == 0) ? fr : fr - 12;
                    *(u32x4*)(EG + ((size_t)blk * 4 + slot) * FF + ch0) = w;
                    if (first || lastr) { const f32x4 v0 = acc[ai][1][m][0], v1 = acc[ai][1][m][1];
                        u32x4 x; x.x = pkbf(v0[0], v0[1]); x.y = pkbf(v0[2], v0[3]); x.z = pkbf(v1[0], v1[1]); x.w = pkbf(v1[2], v1[3]);
                        *(u32x4*)(EV + ((size_t)blk * 2 + (first ? 0 : 1)) * FF + ch0) = x; }
                }
            }
        }
    }
};
__device__ __forceinline__ void transpose_item(const float* __restrict__ W, int K, int N, bf16* __restrict__ WT, int item, int nperm, LAS float* scr, int lane) {
    const int nblk = N >> 6, kb = item / nblk, nb = item - kb * nblk, k0 = kb * 64, n0 = nb * 64;
    f32x4 v[16];
    const float* src = W + (size_t)(k0 + (lane >> 4)) * N + n0 + (lane & 15) * 4;
#pragma unroll
    for (int i = 0; i < 16; ++i) v[i] = *(const f32x4*)(src + (size_t)(4 * i) * N);
    __builtin_amdgcn_sched_barrier(0);
#pragma unroll
    for (int i = 0; i < 16; ++i) *(LAS f32x4*)(scr + (4 * i + (lane >> 4)) * 68 + (lane & 15) * 4) = v[i];
    LDS_WAIT();
    const int c = lane & 7;
#pragma unroll
    for (int j = 0; j < 8; ++j) { const int n = (lane >> 3) + 8 * j; const LAS float* s = scr + (8 * c) * 68 + n;
        u32x4 o; o.x = pkbf(s[0], s[68]); o.y = pkbf(s[2 * 68], s[3 * 68]); o.z = pkbf(s[4 * 68], s[5 * 68]); o.w = pkbf(s[6 * 68], s[7 * 68]);
        int nd = n; if (n0 < nperm) nd = 2 * (16 * (n >> 5) + (n & 15)) + ((n >> 4) & 1);
        *(u32x4*)(WT + (size_t)(n0 + nd) * K + k0 + 8 * c) = o; }
    LDS_WAIT();
}

__device__ __forceinline__ void transpose_wg_item(const float* __restrict__ W, int K, int N, bf16* __restrict__ WT, int item, int mode  , LAS float* scr, int tid, int ldk, int koff  ) {
    const int nblk = N >> 7, kb = item / nblk, nb = item - kb * nblk, k0 = kb * 256, n0 = nb * 128;
    f32x4 v[16];
    const int kr = tid >> 5, n4 = (tid & 31) * 4;
    const float* src = W + (size_t)(k0 + kr) * N + n0 + n4;
#pragma unroll
    for (int i = 0; i < 16; ++i) v[i] = __builtin_nontemporal_load((const f32x4*)(src + (size_t)(16 * i) * N));
    __builtin_amdgcn_sched_barrier(0);
#pragma unroll
    for (int i = 0; i < 16; ++i) { const int k = 16 * i + kr; *(LAS f32x4*)(scr + k * 132 + (n4 ^ (((k >> 3) & 7) << 2))) = v[i]; }
    __syncthreads();
    const int c = tid & 31;
#pragma unroll
    for (int j = 0; j < 8; ++j) { const int n = (tid >> 5) + 16 * j; const LAS float* s = scr + (8 * c) * 132 + (n ^ ((c & 7) << 2));
        u32x4 o; o.x = pkbf(s[0], s[132]); o.y = pkbf(s[2 * 132], s[3 * 132]); o.z = pkbf(s[4 * 132], s[5 * 132]); o.w = pkbf(s[6 * 132], s[7 * 132]);
        int nd = n0 + n;
        if (mode == 1 && n0 < 2048) { const int d = n & 63; nd = n0 + (n & 64) + 2 * (16 * (d >> 5) + (d & 15)) + ((d >> 4) & 1); }
        if (mode == 2) nd = ((n0 % FF) >> 7) * 256 + (n0 >= FF ? 128 : 0) + n;
        __builtin_nontemporal_store(o, (u32x4*)(WT + (size_t)nd * ldk + koff + k0 + 8 * c)); }
    __syncthreads();
}

__device__ __forceinline__ void ada_items(PK P, LAS unsigned char* lds, int l, int widx, int nw) {
    int tid_ = threadIdx.x; asm volatile("" : "+v"(tid_)); const int tid = tid_;
    LAS float* sil = (LAS float*)lds;
    LAS float* red = (LAS float*)(lds + 40960);
    for (int i = tid; i < 5 * DM; i += NTHR) { const float x = (i < 4 * DM) ? P->in[I_C][i] : P->in[I_CCTX][i - 4 * DM]; sil[i] = x / (1.f + __expf(-x)); }
    __syncthreads();
    float* ADA = (float*)(P->ws + WS_ADA);
    const int kg = tid >> 4, n4 = (tid & 15) * 4;
    for (int it = widx; it < 192; it += nw) {
        const int n0 = it * 64;
        const float* wp = P->in[I_WADA] + ((size_t)l * DM + kg) * 12288 + n0 + n4;
        f32x4 a[5];
#pragma unroll
        for (int r = 0; r < 5; ++r) a[r] = (f32x4){0.f, 0.f, 0.f, 0.f};
#pragma unroll 1
        for (int kk0 = 0; kk0 < 64; kk0 += 8) {
            f32x4 w[8];
#pragma unroll
            for (int j = 0; j < 8; ++j) w[j] = __builtin_nontemporal_load((const f32x4*)(wp + (size_t)(32 * (kk0 + j)) * 12288));
            __builtin_amdgcn_sched_barrier(0);
#pragma unroll
            for (int j = 0; j < 8; ++j) { const int k = kg + 32 * (kk0 + j);
#pragma unroll
                for (int r = 0; r < 5; ++r) a[r] += w[j] * sil[r * DM + k]; }
            __builtin_amdgcn_sched_barrier(0);
        }
#pragma unroll
        for (int r = 0; r < 5; ++r) *(LAS f32x4*)(red + (kg * 5 + r) * 64 + n4) = a[r];
        __syncthreads();
        if (tid < 320) { const int r = tid >> 6, n = tid & 63; float s = 0.f;
#pragma unroll 8
            for (int g = 0; g < 32; ++g) s += red[(g * 5 + r) * 64 + n];
            ADA[((size_t)l * 5 + r) * 12288 + n0 + n] = s + P->in[I_BADA][(size_t)l * 12288 + n0 + n]; }
        __syncthreads();
    }
}
__device__ __forceinline__ void filter_items(PK P, LAS unsigned char* lds, int l, int widx, int nw) {
    int tid_ = threadIdx.x; asm volatile("" : "+v"(tid_)); const int tid = tid_;
    unsigned char* ws = P->ws;
    LAS float* zs = (LAS float*)lds;
    LAS float* h1s = (LAS float*)(lds + 8192);
    LAS float* h2s = (LAS float*)(lds + 16384);
    LAS float* w1s = (LAS float*)(lds + 24576);
    LAS float* w2s = (LAS float*)(lds + 36864);
    const int NI = 256 + ((l < DEPTH - 1) ? 32 : 0);
    __syncthreads();
    if (widx < NI) {
        const float* w1 = P->in[I_HW1] + (size_t)l * 33 * 64; const float* w2 = P->in[I_HW2] + (size_t)l * 64 * 64;
        for (int i = tid; i < 33 * 16; i += NTHR) *(LAS f32x4*)(w1s + 4 * i) = *(const f32x4*)(w1 + 4 * i);
        for (int i = tid; i < 64 * 16; i += NTHR) *(LAS f32x4*)(w2s + 4 * i) = *(const f32x4*)(w2 + 4 * i);
    }
    __syncthreads();
    for (int it = widx; it < NI; it += nw) {
        int lag0, combo, L;
        if (it < 256) { lag0 = (it >> 2) * 32; combo = it & 3; L = SEQ; }
        else { const int j = it - 256; lag0 = (j >> 2) * 32; combo = j & 3; L = CTX; }
        { const int li = tid >> 4, j = tid & 15; const float lagf = (float)(lag0 + li);
          const float wang = 6.283185307179586f * lagf / (float)L; const float f = 1e-4f + (float)j * ((15.f - 1e-4f) / 15.f);
          zs[li * 36 + 1 + j] = cosf(f * wang); zs[li * 36 + 17 + j] = -sinf(f * wang); if (j == 0) zs[li * 36] = lagf / (float)(L - 1); }
        __syncthreads();
        { const int li = tid >> 4, u0 = (tid & 15) * 4; f32x4 s = *(const f32x4*)(P->in[I_HB1] + l * 64 + u0);
#pragma unroll 3
          for (int k = 0; k < 33; ++k) s += *(const LAS f32x4*)(w1s + k * 64 + u0) * zs[li * 36 + k];
          const f32x4 fr = *(const f32x4*)(P->in[I_HFREQ] + l * 128 + u0);
          f32x4 o; o.x = sinf(fr.x * s.x); o.y = sinf(fr.y * s.y); o.z = sinf(fr.z * s.z); o.w = sinf(fr.w * s.w); *(LAS f32x4*)(h1s + li * 64 + u0) = o; }
        __syncthreads();
        { const int li = tid >> 4, u0 = (tid & 15) * 4; f32x4 s = *(const f32x4*)(P->in[I_HB2] + l * 64 + u0);
#pragma unroll 4
          for (int k = 0; k < 64; ++k) s += *(const LAS f32x4*)(w2s + k * 64 + u0) * h1s[li * 64 + k];
          const f32x4 fr = *(const f32x4*)(P->in[I_HFREQ] + l * 128 + 64 + u0);
          f32x4 o; o.x = sinf(fr.x * s.x); o.y = sinf(fr.y * s.y); o.z = sinf(fr.z * s.z); o.w = sinf(fr.w * s.w); *(LAS f32x4*)(h2s + li * 64 + u0) = o; }
        __syncthreads();
        {
            const int lane = tid & 63, wv = tid >> 6, r32 = lane & 31, hh = lane >> 5, dir = combo >> 1, o = combo & 1;
            bf16x8 ah[4], al[4];
#pragma unroll
            for (int ks = 0; ks < 4; ++ks) { const LAS float* hp = h2s + r32 * 64 + 16 * ks + 8 * hh; const f32x4 x0 = *(const LAS f32x4*)hp, x1 = *(const LAS f32x4*)(hp + 4);
                const float xv[8] = {x0.x, x0.y, x0.z, x0.w, x1.x, x1.y, x1.z, x1.w}; u32x4 hi4, lo4;
#pragma unroll
                for (int q = 0; q < 4; ++q) { const unsigned h2p = pkbf(xv[2 * q], xv[2 * q + 1]); hi4[q] = h2p; lo4[q] = pkbf(xv[2 * q] - bflo(h2p), xv[2 * q + 1] - bfhi(h2p)); }
                ah[ks] = __builtin_bit_cast(bf16x8, hi4); al[ks] = __builtin_bit_cast(bf16x8, lo4); }
            const float dmin = -3.0701134573253946f, dmax = -15.350567286626973f;
#pragma unroll 1
            for (int nb = 0; nb < 2; ++nb) {
                const int c = (2 * wv + nb) * 32 + r32;
                const float* w3 = P->in[I_HW3] + (size_t)l * 64 * 2048 + combo * 512 + c;
                float wv32[32];
#pragma unroll
                for (int q = 0; q < 32; ++q) wv32[q] = w3[(size_t)(16 * (q >> 3) + 8 * hh + (q & 7)) * 2048];
                f32x16 acc = (f32x16){};
#pragma unroll
                for (int ks = 0; ks < 4; ++ks) {
                    u32x4 hi4, lo4;
#pragma unroll
                    for (int q = 0; q < 4; ++q) { const float a_ = wv32[8 * ks + 2 * q], b_ = wv32[8 * ks + 2 * q + 1]; const unsigned hp2 = pkbf(a_, b_); hi4[q] = hp2; lo4[q] = pkbf(a_ - bflo(hp2), b_ - bfhi(hp2)); }
                    const bf16x8 bh = __builtin_bit_cast(bf16x8, hi4), bl = __builtin_bit_cast(bf16x8, lo4);
                    acc = __builtin_amdgcn_mfma_f32_32x32x16_bf16(ah[ks], bh, acc, 0, 0, 0);
                    acc = __builtin_amdgcn_mfma_f32_32x32x16_bf16(ah[ks], bl, acc, 0, 0, 0);
                    acc = __builtin_amdgcn_mfma_f32_32x32x16_bf16(al[ks], bh, acc, 0, 0, 0); }
                const float delta = fabsf(dmin + (dmax - dmin) * ((float)c / 511.f));
                float* kf = (L == SEQ) ? (float*)(ws + WS_KF) + ((size_t)(l * 2 + o) * 512 + c) * 4096 : (float*)(ws + WS_KFC) + ((size_t)(l * 2 + o) * 512 + c) * 512;
                const float dl2 = -delta * 1.4426950408889634f / (float)(L - 1);
#pragma unroll
                for (int rr = 0; rr < 4; ++rr) { const int lagb = lag0 + 8 * rr + 4 * hh;
                    f32x4 v;
#pragma unroll
                    for (int i = 0; i < 4; ++i) v[i] = acc[4 * rr + i] * exp2f(dl2 * (float)(lagb + i));
                    if (dir == 0) *(f32x4*)(kf + L + lagb) = v;
                    else { if (lagb > 0) kf[L - lagb] = v[0]; kf[L - lagb - 1] = v[1]; kf[L - lagb - 2] = v[2]; kf[L - lagb - 3] = v[3]; } }
            }
        }
        __syncthreads();
    }
}
constexpr int CI_IN = 8 * 88, CI_AO = 4 * 16, CI_HO = 2 * 16, CI_PO = 2 * 16, CI_OUT = 8 * 16, CI_UP = 8 * 88, CI_DN = 22 * 16;
constexpr int CONV_ALL = CI_IN + CI_AO + CI_HO + CI_PO + CI_OUT + CI_UP + CI_DN + 1;
#ifndef CONV_CB
#define CONV_CB 4
#endif
struct ConvIt { const float* src; bf16* WT; int N, n0, k0, mode, ldk, koff; };
__device__ __forceinline__ ConvIt conv_decode(PK P, unsigned char* lw, int l, int it, int tid) {
    int r = it;
    const float* W; int K, N; bf16* WT; int mode = 0, ldk = 0, koff = 0;
    if (r < CI_IN) { W = P->in[I_WIN] + (size_t)l * DM * INW; K = DM; N = INW; WT = (bf16*)(lw + LW_WIN); mode = 1; }
    else if ((r -= CI_IN) < CI_AO) { W = P->in[I_WAO] + (size_t)l * AW * DM; K = AW; N = DM; WT = (bf16*)(lw + LW_WAO); ldk = DM; }
    else if ((r -= CI_AO) < CI_HO) { W = P->in[I_WHO] + (size_t)l * HWD * DM; K = HWD; N = DM; WT = (bf16*)(lw + LW_WAO); ldk = DM; koff = 1024; }
    else if ((r -= CI_HO) < CI_PO) { W = P->in[I_WPO] + (size_t)l * PWD * DM; K = PWD; N = DM; WT = (bf16*)(lw + LW_WAO); ldk = DM; koff = 1536; }
    else if ((r -= CI_PO) < CI_OUT) { W = P->in[I_WOUT] + (size_t)l * DM * DM; K = DM; N = DM; WT = (bf16*)(lw + LW_WOUT); }
    else if ((r -= CI_OUT) < CI_UP) { W = P->in[I_WUP] + (size_t)l * DM * INW; K = DM; N = INW; WT = (bf16*)(lw + LW_WUP); mode = 2; }
    else { r -= CI_UP; W = P->in[I_WDN] + (size_t)l * FF * DM; K = FF; N = DM; WT = (bf16*)(lw + LW_WDN); }
    const int nblk = N >> 7, kb = r / nblk, nb = r - kb * nblk;
    ConvIt c; c.N = N; c.n0 = nb * 128; c.k0 = kb * 256; c.mode = mode; c.ldk = ldk ? ldk : K; c.koff = koff; c.WT = WT;
    c.src = W + (size_t)(c.k0 + (tid >> 5)) * N + c.n0 + (tid & 31) * 4;
    return c;
}
__device__ __forceinline__ void conv_items(PK P, LAS unsigned char* lds, int l, int lo, int hi, int widx, int nw) {
    int tid_ = threadIdx.x; asm volatile("" : "+v"(tid_)); const int tid = tid_, lane = tid & 63, wid = rfl(tid >> 6);
    LAS float* scr = (LAS float*)lds;
    unsigned char* lw = P->ws + WS_W + (size_t)l * LW_SIZE;
    __syncthreads();
    const int hi2 = hi < CONV_ALL - 1 ? hi : CONV_ALL - 1;
    int it = lo + widx;
    const int kr = tid >> 5, n4 = (tid & 31) * 4, c = tid & 31;
    while (it < hi2) {
        const ConvIt cur = conv_decode(P, lw, l, it, tid);
#pragma unroll
        for (int b0 = 0; b0 < 16; b0 += CONV_CB) {
            f32x4 v[CONV_CB];
#pragma unroll
            for (int i = 0; i < CONV_CB; ++i) v[i] = __builtin_nontemporal_load((const f32x4*)(cur.src + (size_t)(16 * (b0 + i)) * cur.N));
            __builtin_amdgcn_sched_barrier(0);
#pragma unroll
            for (int i = 0; i < CONV_CB; ++i) { const int k = 16 * (b0 + i) + kr; *(LAS f32x4*)(scr + k * 132 + (n4 ^ (((k >> 3) & 7) << 2))) = v[i]; }
            __builtin_amdgcn_sched_barrier(0);
        }
        __syncthreads();
#pragma unroll
        for (int j = 0; j < 8; ++j) { const int n = (tid >> 5) + 16 * j; const LAS float* s = scr + (8 * c) * 132 + (n ^ ((c & 7) << 2));
            u32x4 o; o.x = pkbf(s[0], s[132]); o.y = pkbf(s[2 * 132], s[3 * 132]); o.z = pkbf(s[4 * 132], s[5 * 132]); o.w = pkbf(s[6 * 132], s[7 * 132]);
            int nd = cur.n0 + n;
            if (cur.mode == 1 && cur.n0 < 2048) { const int d = n & 63; nd = cur.n0 + (n & 64) + 2 * (16 * (d >> 5) + (d & 15)) + ((d >> 4) & 1); }
            if (cur.mode == 2) nd = ((cur.n0 % FF) >> 7) * 256 + (cur.n0 >= FF ? 128 : 0) + n;
            __builtin_nontemporal_store(o, (u32x4*)(cur.WT + (size_t)nd * cur.ldk + cur.koff + cur.k0 + 8 * c)); }
        __syncthreads();
        it += nw;
    }
    if (lo <= CONV_ALL - 1 && CONV_ALL - 1 < hi && (CONV_ALL - 1 - lo) % nw == widx) {
        LAS float* ws_ = (LAS float*)(lds + wid * 17408);
        for (int q = wid; q < 16; q += NWAVES) { const int g = q >> 2; transpose_item(P->in[I_POOLW] + ((size_t)l * 4 + g) * 128 * 128, 128, 128, (bf16*)(lw + LW_PWT) + (size_t)g * 128 * 128, q & 3, 0, ws_, lane); }
    }
    __syncthreads();
}
__device__ __forceinline__ void misc_tables(PK P) {
    int tid_ = threadIdx.x; asm volatile("" : "+v"(tid_)); const int tid = tid_, lane = tid & 63, wid = rfl(tid >> 6);
    unsigned char* ws = P->ws;
    float* rc = (float*)(ws + WS_ROPE); float* rs = rc + 1024;
    for (int i = tid; i < 1024; i += NTHR) { const int pos = i >> 4, f = i & 15; const float inv = powf(10000.f, -(float)f / 16.f); const float ang = (float)pos * inv; rc[i] = cosf(ang); rs[i] = sinf(ang); }
    if (wid < DEPTH) { const float* lp = P->in[I_DLAM] + wid * 256; const float s1 = wave_sum(lp[lane] * lp[64 + lane]), s2 = wave_sum(lp[128 + lane] * lp[192 + lane]);
        const float li = 0.8f - 0.6f * expf(-0.3f * (float)wid);
        if (lane == 0) { float* sc = (float*)(ws + WS_SC); sc[wid * 2] = expf(s1) - expf(s2) + li; sc[wid * 2 + 1] = 1.f - li; } }
}
__device__ __forceinline__ void prologue_phase(PK P, LAS unsigned char* lds, int vcu, int G) {
    ada_items(P, lds, 0, vcu, G);
    if (vcu == 0) misc_tables(P);
    filter_items(P, lds, 0, vcu, G);
    conv_items(P, lds, 0, 0, CONV_ALL, vcu, G);
}
template <int MODE>
__device__ __forceinline__ void norm_phase(PK P, int vcu, int G, int nrows, const float* __restrict__ ada_l  , int jA,
                                           const float* __restrict__ gA, const bf16* __restrict__ Y, float* out_f32  , bool want_h,
                                           const float* __restrict__ ada_h  , int jShift, int jScale, const float* __restrict__ gB,
                                           const float* __restrict__ slab = nullptr, int nslab = 0  ) {
    int tid_ = threadIdx.x; asm volatile("" : "+v"(tid_)); const int tid = tid_, lane = tid & 63, wid = rfl(tid >> 6);
    bf16* XRES = (bf16*)(P->ws + WS_XRES); bf16* H = (bf16*)(P->ws + WS_H);
    const int stride = G * NWAVES, gw = vcu * NWAVES + wid;
    const bool deal = (nrows == RT) && (stride == 2048);
    const int per = (!deal && nrows % stride == 0) ? nrows / stride : 0;
    const int nmine = deal ? (gw < 1024 ? 4 : 5) : (per ? per : (nrows - gw + stride - 1) / stride);
#define NP_ROW(i) (deal ? (gw < 1024 ? ((i) == 0 ? RX + gw : 3 * gw + ((i) - 1)) : 3072 + 5 * (gw - 1024) + (i)) : (per ? per * gw + (i) : gw + stride * (i)))
    f32x4 xn[8]; u32x2 yn[8], xr2[8];
#define NP_LOAD(r) do { const int r_ = (r); \
        if (MODE == 0) { const float* xr_ = (r_ < RX) ? P->in[I_X] + (size_t)r_ * DM : P->in[I_CTX] + (size_t)(r_ - RX) * DM; \
            _Pragma("unroll") for (int j = 0; j < 8; ++j) xn[j] = *(const f32x4*)(xr_ + 4 * (lane + 64 * j)); } \
        else { const bf16* xr_ = XRES + (size_t)r_ * DM; const bf16* yr_ = Y + (size_t)r_ * DM; \
            _Pragma("unroll") for (int j = 0; j < 8; ++j) { xr2[j] = *(const u32x2*)(xr_ + 4 * (lane + 64 * j)); \
                if (r_ < RX || nslab == 0) yn[j] = *(const u32x2*)(yr_ + 4 * (lane + 64 * j)); } } __builtin_amdgcn_sched_barrier(0); } while (0)
    if (nmine > 0) NP_LOAD(NP_ROW(0));
    f32x4 mg[8], sg[8], sh8[8];
    int acur = -1;
    for (int it = 0; it < nmine; ++it) {
        const int row = NP_ROW(it);
        const int arow = (row < RX) ? (row >> 11) : 4;
        if (arow != acur) {
            acur = arow;
            int lq = lane; asm volatile("" : "+v"(lq));
            if (MODE != 0) { const float* mA = ada_l + (size_t)arow * 12288 + jA * DM;
#pragma unroll
                for (int j0 = 0; j0 < 8; j0 += 4) { f32x4 m[4], g[4];
#pragma unroll
                    for (int j = 0; j < 4; ++j) { const int e = 4 * (lq + 64 * (j0 + j)); m[j] = *(const f32x4*)(mA + e); g[j] = *(const f32x4*)(gA + e); }
                    __builtin_amdgcn_sched_barrier(0);
#pragma unroll
                    for (int j = 0; j < 4; ++j) mg[j0 + j] = m[j] * g[j];
                    __builtin_amdgcn_sched_barrier(0); } }
            if (want_h) { const float* mSh = ada_h + (size_t)arow * 12288 + jShift * DM; const float* mSc = ada_h + (size_t)arow * 12288 + jScale * DM;
#pragma unroll
                for (int j0 = 0; j0 < 8; j0 += 4) { f32x4 sc[4], g[4];
#pragma unroll
                    for (int j = 0; j < 4; ++j) { const int e = 4 * (lq + 64 * (j0 + j)); sh8[j0 + j] = *(const f32x4*)(mSh + e); sc[j] = *(const f32x4*)(mSc + e); g[j] = *(const f32x4*)(gB + e); }
                    __builtin_amdgcn_sched_barrier(0);
#pragma unroll
                    for (int j = 0; j < 4; ++j) sg[j0 + j] = g[j] * (sc[j] + 1.f);
                    __builtin_amdgcn_sched_barrier(0); } }
        }
        f32x4 x[8];
#pragma unroll
        for (int j = 0; j < 8; ++j) x[j] = (MODE == 0) ? xn[j] : (f32x4){bflo(xr2[j].x), bfhi(xr2[j].x), bflo(xr2[j].y), bfhi(xr2[j].y)};
        if (MODE != 0) {
            f32x4 y[8]; float ss = 0.f;
#pragma unroll
            for (int j = 0; j < 8; ++j) {
                if (row < RX || nslab == 0) y[j] = (f32x4){bflo(yn[j].x), bfhi(yn[j].x), bflo(yn[j].y), bfhi(yn[j].y)};
                else { const bf16* sp = (const bf16*)slab + (size_t)(row - RX) * DM + 4 * (lane + 64 * j); y[j] = (f32x4){0.f, 0.f, 0.f, 0.f};
                    for (int s = 0; s < nslab; ++s) { const u32x2 u = *(const u32x2*)(sp + (size_t)s * RC * DM); y[j] += (f32x4){bflo(u.x), bfhi(u.x), bflo(u.y), bfhi(u.y)}; } }
                ss += (y[j].x * y[j].x + y[j].y * y[j].y) + (y[j].z * y[j].z + y[j].w * y[j].w); }
            const float rstd = rsqrtf(wave_sum(ss) * (1.f / DM) + EPS);
#pragma unroll
            for (int j = 0; j < 8; ++j) x[j] += mg[j] * (y[j] * rstd);
            __builtin_amdgcn_sched_barrier(0);
            if (it + 1 < nmine) NP_LOAD(NP_ROW(it + 1));
        } else { if (it + 1 < nmine) NP_LOAD(NP_ROW(it + 1)); }
        if (out_f32) { float* xo = out_f32 + (size_t)row * DM;
#pragma unroll
          for (int j = 0; j < 8; ++j) *(f32x4*)(xo + 4 * (lane + 64 * j)) = x[j]; }
        else { bf16* xo = XRES + (size_t)row * DM;
#pragma unroll
          for (int j = 0; j < 8; ++j) { u32x2 o; o.x = pkbf(x[j].x, x[j].y); o.y = pkbf(x[j].z, x[j].w); *(u32x2*)(xo + 4 * (lane + 64 * j)) = o;
              x[j] = (f32x4){bflo(o.x), bfhi(o.x), bflo(o.y), bfhi(o.y)}; } }
        if (want_h) {
            float ss = 0.f;
#pragma unroll
            for (int j = 0; j < 8; ++j) ss += (x[j].x * x[j].x + x[j].y * x[j].y) + (x[j].z * x[j].z + x[j].w * x[j].w);
            const float rstd = rsqrtf(wave_sum(ss) * (1.f / DM) + EPS);
            bf16* hr = H + (size_t)row * DM;
#pragma unroll
            for (int j = 0; j < 8; ++j) { const int e = 4 * (lane + 64 * j); const f32x4 h = (x[j] * rstd) * sg[j] + sh8[j]; u32x2 o; o.x = pkbf(h.x, h.y); o.y = pkbf(h.z, h.w); *(u32x2*)(hr + e) = o; }
        }
    }
#undef NP_LOAD
#undef NP_ROW
}

__device__ __forceinline__ void act_edge_phase(PK P, int vcu, int G, int nrows, const float* __restrict__ cw  ) {
    int tid_ = threadIdx.x; asm volatile("" : "+v"(tid_)); const int tid = tid_;
    const bf16* EG = (const bf16*)(P->ws + WS_EG); const bf16* EV = (const bf16*)(P->ws + WS_EV); bf16* ACT = (bf16*)(P->ws + WS_ACT);
    const int nblk = nrows >> 6, nitems = nblk * 2 * (FF / 8);
    for (int it = vcu * NTHR + tid; it < nitems; it += G * NTHR) {
        const int cch = it % (FF / 8), rb = it / (FF / 8), b = rb >> 1, lastr = rb & 1, ch = cch * 8;
        const int row = b * 64 + (lastr ? 63 : 0);
        const int tq = (row < RX) ? (row & (SEQ - 1)) : ((row - RX) & (CTX - 1)); const int Ls = (row < RX) ? SEQ : CTX;
        u32x4 up = {0u, 0u, 0u, 0u}, dn = {0u, 0u, 0u, 0u}, cur, vv;
        if (!lastr) { cur = *(const u32x4*)(EG + ((size_t)b * 4 + 0) * FF + ch); dn = *(const u32x4*)(EG + ((size_t)b * 4 + 1) * FF + ch); vv = *(const u32x4*)(EV + ((size_t)b * 2 + 0) * FF + ch);
            if (tq > 0) up = *(const u32x4*)(EG + ((size_t)(b - 1) * 4 + 3) * FF + ch); }
        else { cur = *(const u32x4*)(EG + ((size_t)b * 4 + 3) * FF + ch); up = *(const u32x4*)(EG + ((size_t)b * 4 + 2) * FF + ch); vv = *(const u32x4*)(EV + ((size_t)b * 2 + 1) * FF + ch);
            if (tq + 1 < Ls) dn = *(const u32x4*)(EG + ((size_t)(b + 1) * 4 + 0) * FF + ch); }
        float w0[8], w1[8], w2[8];
#pragma unroll
        for (int i = 0; i < 8; i += 4) { *(f32x4*)(w0 + i) = *(const f32x4*)(cw + ch + i); *(f32x4*)(w1 + i) = *(const f32x4*)(cw + FF + ch + i); *(f32x4*)(w2 + i) = *(const f32x4*)(cw + 2 * FF + ch + i); }
        float o[8];
#pragma unroll
        for (int q = 0; q < 4; ++q) {
            o[2 * q] = gelu_tanh_f(w0[2 * q] * bflo(up[q]) + w1[2 * q] * bflo(cur[q]) + w2[2 * q] * bflo(dn[q])) * bflo(vv[q]);
            o[2 * q + 1] = gelu_tanh_f(w0[2 * q + 1] * bfhi(up[q]) + w1[2 * q + 1] * bfhi(cur[q]) + w2[2 * q + 1] * bfhi(dn[q])) * bfhi(vv[q]);
        }
        u32x4 w; w.x = pkbf(o[0], o[1]); w.y = pkbf(o[2], o[3]); w.z = pkbf(o[4], o[5]); w.w = pkbf(o[6], o[7]);
        *(u32x4*)(ACT + (size_t)row * FF + ch) = w;
    }
}

constexpr int AT_STAGE = 32768;
__device__ __forceinline__ s16x4 vtr(const LAS unsigned char* p) { typedef short v4i16_t __attribute__((ext_vector_type(4))); return __builtin_bit_cast(s16x4, __builtin_amdgcn_ds_read_tr16_b64_v4i16((LAS v4i16_t*)p)); }

#define DS_RD128(dst, addr, OFF) asm volatile("ds_read_b128 %0, %1 offset:%2" : "=&v"(dst) : "v"(addr), "n"(OFF))
#define DS_RDTR(dst, addr, OFF) asm volatile("ds_read_b64_tr_b16 %0, %1 offset:%2" : "=&v"(dst) : "v"(addr), "n"(OFF))
#define V_READ(S, blk) do { DS_RDTR(S[0], vaddr, ((blk) * 4 + 0) * 1024); DS_RDTR(S[1], vaddr, ((blk) * 4 + 0) * 1024 + 512); DS_RDTR(S[2], vaddr, ((blk) * 4 + 1) * 1024); DS_RDTR(S[3], vaddr, ((blk) * 4 + 1) * 1024 + 512); \
        DS_RDTR(S[4], vaddr, ((blk) * 4 + 2) * 1024); DS_RDTR(S[5], vaddr, ((blk) * 4 + 2) * 1024 + 512); DS_RDTR(S[6], vaddr, ((blk) * 4 + 3) * 1024); DS_RDTR(S[7], vaddr, ((blk) * 4 + 3) * 1024 + 512); } while (0)
#define V_WAIT(N, S) asm volatile("s_waitcnt lgkmcnt(" #N ")" : "+v"(S[0]), "+v"(S[1]), "+v"(S[2]), "+v"(S[3]), "+v"(S[4]), "+v"(S[5]), "+v"(S[6]), "+v"(S[7]))
#define PV4(blk, S) do { _Pragma("unroll") for (int ks_ = 0; ks_ < 4; ++ks_) { const bf16x8 vf_ = {S[2 * ks_][0], S[2 * ks_][1], S[2 * ks_][2], S[2 * ks_][3], S[2 * ks_ + 1][0], S[2 * ks_ + 1][1], S[2 * ks_ + 1][2], S[2 * ks_ + 1][3]}; \
        o[blk] = __builtin_amdgcn_mfma_f32_32x32x16_bf16(vf_, __builtin_bit_cast(bf16x8, pw[ks_]), o[blk], 0, 0, 0); } } while (0)
__device__ __forceinline__ void attn_unit(LAS unsigned char* lds, const bf16* __restrict__ QKV, bf16* __restrict__ MIXA, float lam, float oscale, const float* __restrict__ subg,
                                          int b, int h, int qb, bool isctx) {
    int tid_ = threadIdx.x; asm volatile("" : "+v"(tid_)); const int tid = tid_, lane = tid & 63, wid = rfl(tid >> 6), r32 = lane & 31, hi = lane >> 5;
    const int mp = wid & 1, g = wid >> 1;
    const int seq0 = isctx ? RX + b * CTX : b * SEQ, ctx0 = RX + b * CTX;
    const int qrow = seq0 + qb * 128 + g * 32 + r32;
    const int NT = isctx ? 4 : 36;
    bf16x8 qf[4];
    { const bf16* qp = QKV + (size_t)qrow * NQKV + h * 128 + mp * 64 + hi * 8;
#pragma unroll
      for (int d0 = 0; d0 < 4; ++d0) qf[d0] = *(const bf16x8*)(qp + d0 * 16); }
    const int kkey = 8 * wid + (lane >> 3);
    const bf16* kbase = QKV + 1024 + h * 128 + (size_t)kkey * NQKV + (((lane & 7) ^ ((kkey >> 1) & 7)) << 3);
    const bf16* vbase = QKV + 2048 + h * 128 + (wid >> 1) * 32 + (lane & 3) * 8;
    const int vrow = 16 * ((2 * wid) & 3) + (lane >> 2);
    const int kdst = wid * 1024 + lane * 16, vdst = 16384 + (2 * wid) * 1024 + lane * 16;
#define AT_KROW(t) (isctx ? seq0 + 64 * (t) : ((t) < 32 ? seq0 + 64 * (t) : ctx0 + 64 * ((t) - 32)))
#define AT_DMA(t, st) do { const int kr_ = AT_KROW(t); LAS unsigned char* b_ = lds + (st) * AT_STAGE; const bf16* kp_ = kbase + (size_t)kr_ * NQKV; const bf16* vp_ = vbase + (size_t)(kr_ + vrow) * NQKV; \
        __builtin_amdgcn_global_load_lds((const unsigned*)kp_, (LAS unsigned*)(b_ + wid * 1024), 16, 0, 0); \
        __builtin_amdgcn_global_load_lds((const unsigned*)(kp_ + 64), (LAS unsigned*)(b_ + 8192 + wid * 1024), 16, 0, 0); \
        __builtin_amdgcn_global_load_lds((const unsigned*)vp_, (LAS unsigned*)(b_ + 16384 + (2 * wid) * 1024), 16, 0, 0); \
        __builtin_amdgcn_global_load_lds((const unsigned*)(vp_ + (size_t)16 * NQKV), (LAS unsigned*)(b_ + 16384 + (2 * wid + 1) * 1024), 16, 0, 0); } while (0)
#define AT_BAR(N) do { asm volatile("s_waitcnt vmcnt(" #N ")" ::: "memory"); __builtin_amdgcn_s_barrier(); asm volatile("" ::: "memory"); } while (0)
    AT_DMA(0, 0); if (NT > 1) AT_DMA(1, 1);
    if (NT > 1) AT_BAR(4); else AT_BAR(0);
    f32x16 o[4];
#pragma unroll
    for (int i = 0; i < 4; ++i) o[i] = (f32x16){};
    float mref = 0.f, lrun = 0.f;
    f32x16 negm = (f32x16){};
    int kofs[4];
#pragma unroll
    for (int d0 = 0; d0 < 4; ++d0) kofs[d0] = mp * 8192 + r32 * 128 + (((2 * d0 + hi) ^ ((r32 >> 1) & 7)) << 4);
    const int voff = 16384 + (4 * hi + ((lane & 15) >> 2)) * 64 + ((lane >> 4) & 1) * 32 + (lane & 3) * 8;
    u32x4 pw[4];
    int sc = 0, sp = 2;
#define QK_TILE() \
        f32x16 p0 = negm, p1 = negm; \
        { const unsigned kst = (unsigned)(uintptr_t)(lds + sc * AT_STAGE); bf16x8 kf[8]; \
          DS_RD128(kf[0], kst + kofs[0], 0); DS_RD128(kf[1], kst + kofs[0], 4096); DS_RD128(kf[2], kst + kofs[1], 0); DS_RD128(kf[3], kst + kofs[1], 4096); \
          DS_RD128(kf[4], kst + kofs[2], 0); DS_RD128(kf[5], kst + kofs[2], 4096); DS_RD128(kf[6], kst + kofs[3], 0); DS_RD128(kf[7], kst + kofs[3], 4096); \
          asm volatile("s_waitcnt lgkmcnt(6)" : "+v"(kf[0]), "+v"(kf[1])); \
          p0 = __builtin_amdgcn_mfma_f32_32x32x16_bf16(kf[0], qf[0], p0, 0, 0, 0); p1 = __builtin_amdgcn_mfma_f32_32x32x16_bf16(kf[1], qf[0], p1, 0, 0, 0); \
          asm volatile("s_waitcnt lgkmcnt(4)" : "+v"(kf[2]), "+v"(kf[3])); \
          p0 = __builtin_amdgcn_mfma_f32_32x32x16_bf16(kf[2], qf[1], p0, 0, 0, 0); p1 = __builtin_amdgcn_mfma_f32_32x32x16_bf16(kf[3], qf[1], p1, 0, 0, 0); \
          asm volatile("s_waitcnt lgkmcnt(2)" : "+v"(kf[4]), "+v"(kf[5])); \
          p0 = __builtin_amdgcn_mfma_f32_32x32x16_bf16(kf[4], qf[2], p0, 0, 0, 0); p1 = __builtin_amdgcn_mfma_f32_32x32x16_bf16(kf[5], qf[2], p1, 0, 0, 0); \
          asm volatile("s_waitcnt lgkmcnt(0)" : "+v"(kf[6]), "+v"(kf[7])); \
          p0 = __builtin_amdgcn_mfma_f32_32x32x16_bf16(kf[6], qf[3], p0, 0, 0, 0); p1 = __builtin_amdgcn_mfma_f32_32x32x16_bf16(kf[7], qf[3], p1, 0, 0, 0); }
#define ROWMAX(rm) do { asm volatile("s_nop 15\n\ts_nop 7" : "+v"(p0), "+v"(p1)); \
        float a_ = max3f(p0[0], p0[1], p1[0]), b_ = max3f(p0[2], p0[3], p1[1]); a_ = max3f(a_, p1[2], p1[3]); \
        _Pragma("unroll") for (int r = 4; r < 16; r += 4) { a_ = max3f(a_, p0[r], p0[r + 1]); b_ = max3f(b_, p0[r + 2], p0[r + 3]); a_ = max3f(a_, p1[r], p1[r + 1]); b_ = max3f(b_, p1[r + 2], p1[r + 3]); } \
        rm = xhalf_max(max3f(a_, b_, b_)); } while (0)
#define EXP8(P, B, ls) do { _Pragma("unroll") for (int r = (B); r < (B) + 8; ++r) { P[r] = __builtin_amdgcn_exp2f(P[r]); ls += P[r]; } } while (0)
#define PACK_P() do { _Pragma("unroll") for (int s_ = 0; s_ < 2; ++s_) { \
            pw[s_] = (u32x4){pkbf(p0[8 * s_], p0[8 * s_ + 1]), pkbf(p0[8 * s_ + 2], p0[8 * s_ + 3]), pkbf(p0[8 * s_ + 4], p0[8 * s_ + 5]), pkbf(p0[8 * s_ + 6], p0[8 * s_ + 7])}; \
            pw[2 + s_] = (u32x4){pkbf(p1[8 * s_], p1[8 * s_ + 1]), pkbf(p1[8 * s_ + 2], p1[8 * s_ + 3]), pkbf(p1[8 * s_ + 4], p1[8 * s_ + 5]), pkbf(p1[8 * s_ + 6], p1[8 * s_ + 7])}; } } while (0)
    {
        if (NT > 2) AT_DMA(2, 2);
        __builtin_amdgcn_sched_barrier(0);
        QK_TILE();
        float rm; ROWMAX(rm);
        mref = rm;
#pragma unroll
        for (int r = 0; r < 16; ++r) { p0[r] -= rm; p1[r] -= rm; negm[r] = -mref; }
        float ls = 0.f; EXP8(p0, 0, ls); EXP8(p0, 8, ls); EXP8(p1, 0, ls); EXP8(p1, 8, ls);
        lrun = ls;
        PACK_P();
        __builtin_amdgcn_sched_barrier(0);
        if (NT > 2) AT_BAR(4); else AT_BAR(0);
    }
    sp = 0; sc = 1;
    for (int t = 1; t < NT; ++t) {
        if (t + 2 < NT) AT_DMA(t + 2, (sc + 2) & 3);
        __builtin_amdgcn_sched_barrier(0);
        const unsigned vaddr = (unsigned)(uintptr_t)(lds + sp * AT_STAGE + voff);
        s16x4 va[8], vb[8];
        V_READ(va, 0);
        QK_TILE();
        float rm; ROWMAX(rm);
        const bool resc = __any(rm > 8.f);
        float alpha = 1.f;
        if (__builtin_expect(resc, 0)) { asm volatile("; rescale (rare): keep this a real branch" ::: "memory");
            const float dl = fmaxf(rm, 0.f); alpha = __builtin_amdgcn_exp2f(-dl); mref += dl;
#pragma unroll
            for (int r = 0; r < 16; ++r) { p0[r] -= dl; p1[r] -= dl; negm[r] = -mref; } }
        float ls = 0.f;
#define PV_STEP(blk, S, ks, P, r0) do { const bf16x8 vf_ = {S[2 * (ks)][0], S[2 * (ks)][1], S[2 * (ks)][2], S[2 * (ks)][3], S[2 * (ks) + 1][0], S[2 * (ks) + 1][1], S[2 * (ks) + 1][2], S[2 * (ks) + 1][3]}; \
            o[blk] = __builtin_amdgcn_mfma_f32_32x32x16_bf16(vf_, __builtin_bit_cast(bf16x8, pw[ks]), o[blk], 0, 0, 0); \
            P[r0] = __builtin_amdgcn_exp2f(P[r0]); P[(r0) + 1] = __builtin_amdgcn_exp2f(P[(r0) + 1]); ls += P[r0] + P[(r0) + 1]; asm volatile("" : "+v"(P), "+v"(ls)); __builtin_amdgcn_sched_barrier(0); } while (0)
        V_READ(vb, 1); V_WAIT(8, va); PV_STEP(0, va, 0, p0, 0); PV_STEP(0, va, 1, p0, 2); PV_STEP(0, va, 2, p0, 4); PV_STEP(0, va, 3, p0, 6);
        V_READ(va, 2); V_WAIT(8, vb); PV_STEP(1, vb, 0, p0, 8); PV_STEP(1, vb, 1, p0, 10); PV_STEP(1, vb, 2, p0, 12); PV_STEP(1, vb, 3, p0, 14);
        V_READ(vb, 3); V_WAIT(8, va); PV_STEP(2, va, 0, p1, 0); PV_STEP(2, va, 1, p1, 2); PV_STEP(2, va, 2, p1, 4); PV_STEP(2, va, 3, p1, 6);
        V_WAIT(0, vb); PV_STEP(3, vb, 0, p1, 8); PV_STEP(3, vb, 1, p1, 10); PV_STEP(3, vb, 2, p1, 12); PV_STEP(3, vb, 3, p1, 14);
#undef PV_STEP
        if (__builtin_expect(resc, 0)) { asm volatile("; rescale (rare)" ::: "memory"); lrun *= alpha;
#pragma unroll
            for (int i = 0; i < 4; ++i) o[i] *= alpha; }
        lrun += ls;
        PACK_P();
        __builtin_amdgcn_sched_barrier(0);
        if (t + 2 < NT) AT_BAR(4); else AT_BAR(0);
        sp = sc; sc = (sc + 1) & 3;
    }
    {
        const unsigned vaddr = (unsigned)(uintptr_t)(lds + sp * AT_STAGE + voff);
        s16x4 va[8], vb[8];
        V_READ(va, 0);
        V_READ(vb, 1); V_WAIT(8, va); PV4(0, va);
        V_READ(va, 2); V_WAIT(8, vb); PV4(1, vb);
        V_READ(vb, 3); V_WAIT(8, va); PV4(2, va);
        V_WAIT(0, vb); PV4(3, vb);
    }
    __syncthreads();
#undef QK_TILE
#undef ROWMAX
#undef EXP8
#undef PACK_P
#undef AT_KROW
#undef AT_DMA
#undef AT_BAR
#undef DS_RD128
#undef DS_RDTR
#undef V_READ
#undef V_WAIT
#undef PV4
    const float inv = 1.f / xhalf_sum(lrun);
    LAS float* ex = (LAS float*)(lds + g * 16384) + lane;
    if (mp == 1) {
#pragma unroll
        for (int blk = 0; blk < 4; ++blk)
#pragma unroll
            for (int r = 0; r < 16; ++r) ex[(blk * 16 + r) * 64] = o[blk][r] * inv;
    }
    __syncthreads();
    if (mp == 0) {
        float ss = 0.f;
#pragma unroll
        for (int blk = 0; blk < 4; ++blk)
#pragma unroll
            for (int r = 0; r < 16; ++r) { const float d = o[blk][r] * inv - lam * ex[(blk * 16 + r) * 64]; o[blk][r] = d; ss += d * d; }
        ss = xhalf_sum(ss);
        const float rs = rsqrtf(ss * (1.f / 128.f) + EPS) * oscale;
        bf16* op = MIXA + (size_t)qrow * DM + h * 128 + 4 * hi;
#pragma unroll
        for (int blk = 0; blk < 4; ++blk)
#pragma unroll
            for (int rr = 0; rr < 4; ++rr) { const int vd = 32 * blk + 8 * rr; const f32x4 gg = *(const f32x4*)(subg + vd + 4 * hi);
                u32x2 w; w.x = pkbf(o[blk][4 * rr] * rs * gg.x, o[blk][4 * rr + 1] * rs * gg.y); w.y = pkbf(o[blk][4 * rr + 2] * rs * gg.z, o[blk][4 * rr + 3] * rs * gg.w);
                *(u32x2*)(op + vd) = w; }
    }
    __syncthreads();
}
constexpr int HY_FC = 0, HY_FCS = 8224, HY_U = 8 * HY_FCS, HY_US = 5008  , HY_XS = 4112  , HY_X1 = HY_U + 4 * HY_US, HY_X2 = HY_X1 + 4 * HY_XS,
              HY_KFS = HY_X2 + 4 * HY_XS  , HY_RED = HY_KFS + 16384 + 128, HY_END = HY_RED + 64;
static_assert(HY_END <= MISC_OFF, "hyena LDS");

struct HyRegs { u32x4 ch[3][2]; unsigned hp[3][2], hn[3][2]; float k0[8], k1[8]; };
__device__ __forceinline__ void hy_load(HyRegs& R, PK P, int l, int c, bool isctx, int tid) {
    const int L = isctx ? CTX : SEQ, row0 = isctx ? RX : 0, l8 = L >> 3, nch = 4 * l8;
    const bf16* HYT = (const bf16*)(P->ws + WS_HYT);
#pragma unroll
    for (int a = 0; a < 3; ++a)
#pragma unroll
        for (int j = 0; j < 2; ++j) {
            const int e = min(tid + NTHR * j, nch - 1);
            const int n = e / l8, t0 = (e - n * l8) * 8;
            const bf16* sp = HYT + (size_t)(a * 512 + c) * RT + row0 + (size_t)n * L + t0;
            R.ch[a][j] = *(const u32x4*)sp;
            R.hp[a][j] = *(const unsigned*)(sp + ((t0 > 0) ? -2 : 0));
            R.hn[a][j] = *(const unsigned*)(sp + ((t0 + 8 < L) ? 8 : 6));
        }
    const float* kf0 = isctx ? (const float*)(P->ws + WS_KFC) + ((size_t)(l * 2) * 512 + c) * 512 : (const float*)(P->ws + WS_KF) + ((size_t)(l * 2) * 512 + c) * 4096;
    const float* kf1 = kf0 + (isctx ? (size_t)512 * 512 : (size_t)512 * 4096);
#pragma unroll
    for (int j = 0; j < 8; ++j) { const int i = min(max(tid + NTHR * j, 1), 2 * L - 1); R.k0[j] = kf0[i]; R.k1[j] = kf1[i]; }
    __builtin_amdgcn_sched_barrier(0);
}
__device__ __forceinline__ void hy_fill_conv3(LAS unsigned char* dst, int dstS, int pad, const u32x4 (&ch)[2], const unsigned (&hp)[2], const unsigned (&hn)[2], int L, float w0, float w1, float w2, int tid) {
    const int l8 = L >> 3, nch = 4 * l8;
#pragma unroll
    for (int j = 0; j < 2; ++j) {
        const int e = tid + NTHR * j;
        if (e < nch) {
            const int n = e / l8, t0 = (e - n * l8) * 8; const u32x4 v = ch[j];
            float x[10] = {(t0 > 0) ? bfhi(hp[j]) : 0.f, bflo(v.x), bfhi(v.x), bflo(v.y), bfhi(v.y), bflo(v.z), bfhi(v.z), bflo(v.w), bfhi(v.w), (t0 + 8 < L) ? bflo(hn[j]) : 0.f};
            u32x4 o;
            o.x = pkbf(w0 * x[0] + w1 * x[1] + w2 * x[2], w0 * x[1] + w1 * x[2] + w2 * x[3]); o.y = pkbf(w0 * x[2] + w1 * x[3] + w2 * x[4], w0 * x[3] + w1 * x[4] + w2 * x[5]);
            o.z = pkbf(w0 * x[4] + w1 * x[5] + w2 * x[6], w0 * x[5] + w1 * x[6] + w2 * x[7]); o.w = pkbf(w0 * x[6] + w1 * x[7] + w2 * x[8], w0 * x[7] + w1 * x[8] + w2 * x[9]);
            *(LAS u32x4*)(dst + n * dstS + (pad + t0) * 2) = o;
        }
    }
}
__device__ __forceinline__ float hy_fill_filter(LAS unsigned char* lds, const float (&kf)[8], int L, int tid, int lane, int wid) {
    LAS float* kfs = (LAS float*)(lds + HY_KFS) + 16; LAS float* red = (LAS float*)(lds + HY_RED);
    float s = 0.f;
#pragma unroll
    for (int j = 0; j < 8; ++j) { const int i = tid + NTHR * j; if (i < 2 * L) { const float kv = (i >= 1) ? kf[j] : 0.f; kfs[i] = kv; s += fabsf(kv); } }
    if (tid < 24) kfs[tid < 16 ? tid - 16 : 2 * L + tid - 16] = 0.f;
    s = wave_sum(s);
    if (lane == 0) red[wid] = s;
    __syncthreads();
    float tot = 0.f;
#pragma unroll
    for (int i = 0; i < 8; ++i) tot += red[i];
    const int ny8 = (2 * L + 16) >> 3;
    for (int e = tid; e < ny8; e += NTHR) {
        const int y0 = e * 8;
        float w[16];
#pragma unroll
        for (int k4 = 0; k4 < 16; k4 += 4) *(f32x4*)(w + k4) = *(const LAS f32x4*)(kfs + 2 * L - y0 - 8 + k4);
#pragma unroll
        for (int rho = 0; rho < 8; ++rho) {
            u32x4 o; o.x = pkbf(w[rho + 8], w[rho + 7]); o.y = pkbf(w[rho + 6], w[rho + 5]); o.z = pkbf(w[rho + 4], w[rho + 3]); o.w = pkbf(w[rho + 2], w[rho + 1]);
            *(LAS u32x4*)(lds + HY_FC + rho * HY_FCS + y0 * 2) = o; }
    }
    return 1.f / (tot + EPS);
}
__device__ __forceinline__ f32x16 hy_conv_tile(const LAS unsigned char* lds, int L, int a0, int lane) {
    const int i = lane & 31, h = lane >> 5, q = i >> 2, n = i & 3, nb = L >> 5;
    f32x16 acc = (f32x16){};
    const int dlo = a0 - (nb - 1), dhi = a0 + 7;
    const LAS unsigned char* ap = lds + HY_FC + (i & 7) * HY_FCS + 2 * (L + 8 * h - 8 * (i >> 3) - 32 * dlo);
    const LAS unsigned char* bp = lds + HY_U + n * HY_US + 2 * (224 + 32 * (a0 - dlo + q) + 8 * h);
    f32x16 acc2 = (f32x16){};
    bf16x8 A0 = *(const LAS bf16x8*)ap, A1 = *(const LAS bf16x8*)(ap + 32), B0 = *(const LAS bf16x8*)bp, B1 = *(const LAS bf16x8*)(bp + 32);
    for (int d = dlo; d < dhi; ++d) {
        ap -= 64; bp -= 64;
        const bf16x8 nA0 = *(const LAS bf16x8*)ap, nA1 = *(const LAS bf16x8*)(ap + 32), nB0 = *(const LAS bf16x8*)bp, nB1 = *(const LAS bf16x8*)(bp + 32);
        acc = __builtin_amdgcn_mfma_f32_32x32x16_bf16(A0, B0, acc, 0, 0, 0);
        acc2 = __builtin_amdgcn_mfma_f32_32x32x16_bf16(A1, B1, acc2, 0, 0, 0);
        A0 = nA0; A1 = nA1; B0 = nB0; B1 = nB1;
    }
    acc = __builtin_amdgcn_mfma_f32_32x32x16_bf16(A0, B0, acc, 0, 0, 0);
    acc2 = __builtin_amdgcn_mfma_f32_32x32x16_bf16(A1, B1, acc2, 0, 0, 0);
    return acc + acc2;
}

__device__ __forceinline__ void hyena_compute(LAS unsigned char* lds, PK P, const HyRegs& R, int l, int c, bool isctx) {
    int tid_ = threadIdx.x; asm volatile("" : "+v"(tid_)); const int tid = tid_, lane = tid & 63, wid = rfl(tid >> 6);
    const int L = isctx ? CTX : SEQ, row0 = isctx ? RX : 0, ntile = L >> 8;
    bf16* MIXA = (bf16*)(P->ws + WS_MIXA);
    const float* sw = P->in[I_HYSW] + (size_t)l * 3 * 1536;
    const float bias0 = P->in[I_HBIAS][(size_t)l * 1024 + c], bias1 = P->in[I_HBIAS][(size_t)l * 1024 + 512 + c];
    for (int e = tid; e < 4 * 448 / 8; e += NTHR) { const int n = e / 56, k = e - n * 56; const int off = (k < 28) ? k * 16 : (224 + L) * 2 + (k - 28) * 16;
        *(LAS u32x4*)(lds + HY_U + n * HY_US + off) = (u32x4){0u, 0u, 0u, 0u}; }
    hy_fill_conv3(lds + HY_U, HY_US, 224, R.ch[0], R.hp[0], R.hn[0], L, sw[c], sw[1536 + c], sw[3072 + c], tid);
    hy_fill_conv3(lds + HY_X1, HY_XS, 0, R.ch[1], R.hp[1], R.hn[1], L, sw[512 + c], sw[1536 + 512 + c], sw[3072 + 512 + c], tid);
    hy_fill_conv3(lds + HY_X2, HY_XS, 0, R.ch[2], R.hp[2], R.hn[2], L, sw[1024 + c], sw[1536 + 1024 + c], sw[3072 + 1024 + c], tid);
    const float inv0 = hy_fill_filter(lds, R.k0, L, tid, lane, wid);
    __syncthreads();
    const int a0 = 8 * wid, i32 = lane & 31, h = lane >> 5, q = i32 >> 2, n = i32 & 3;
    const int tb = 32 * (a0 + q) + 4 * h;
    u32x2 zpk[4];
    if (wid < ntile) {
        const f32x16 acc = hy_conv_tile(lds, L, a0, lane);
#pragma unroll
        for (int rr = 0; rr < 4; ++rr) { const int t = tb + 8 * rr;
            const u32x2 uv = *(const LAS u32x2*)(lds + HY_U + n * HY_US + (224 + t) * 2), x1 = *(const LAS u32x2*)(lds + HY_X1 + n * HY_XS + t * 2);
            const float y0 = acc[4 * rr] * inv0 + bflo(uv.x) * bias0, y1 = acc[4 * rr + 1] * inv0 + bfhi(uv.x) * bias0, y2 = acc[4 * rr + 2] * inv0 + bflo(uv.y) * bias0, y3 = acc[4 * rr + 3] * inv0 + bfhi(uv.y) * bias0;
            zpk[rr].x = pkbf(bflo(x1.x) * y0, bfhi(x1.x) * y1); zpk[rr].y = pkbf(bflo(x1.y) * y2, bfhi(x1.y) * y3); }
    }
    __syncthreads();
    if (wid < ntile) {
#pragma unroll
        for (int rr = 0; rr < 4; ++rr) *(LAS u32x2*)(lds + HY_U + n * HY_US + (224 + tb + 8 * rr) * 2) = zpk[rr];
    }
    const float inv1 = hy_fill_filter(lds, R.k1, L, tid, lane, wid);
    __syncthreads();
    if (wid < ntile) {
        const f32x16 acc = hy_conv_tile(lds, L, a0, lane);
        bf16* op = MIXA + (size_t)(row0 + n * L) * DM + 1024 + c;
#pragma unroll
        for (int rr = 0; rr < 4; ++rr) { const int t = tb + 8 * rr;
            const u32x2 x2 = *(const LAS u32x2*)(lds + HY_X2 + n * HY_XS + t * 2);
            const float z0 = bflo(zpk[rr].x), z1 = bfhi(zpk[rr].x), z2 = bflo(zpk[rr].y), z3 = bfhi(zpk[rr].y);
            const float o0 = bflo(x2.x) * (acc[4 * rr] * inv1 + z0 * bias1), o1 = bfhi(x2.x) * (acc[4 * rr + 1] * inv1 + z1 * bias1);
            const float o2 = bflo(x2.y) * (acc[4 * rr + 2] * inv1 + z2 * bias1), o3 = bfhi(x2.y) * (acc[4 * rr + 3] * inv1 + z3 * bias1);
            const unsigned a = pkbf(o0, o1), bq = pkbf(o2, o3);
            op[(size_t)t * DM] = (bf16)(a & 0xffffu); op[(size_t)(t + 1) * DM] = (bf16)(a >> 16); op[(size_t)(t + 2) * DM] = (bf16)(bq & 0xffffu); op[(size_t)(t + 3) * DM] = (bf16)(bq >> 16); }
    }
    __syncthreads();
}
__device__ __forceinline__ void hyena_parts(LAS unsigned char* lds, PK P, int l, int vcu, int G, bool last) {
    int tid_ = threadIdx.x; asm volatile("" : "+v"(tid_)); const int tid = tid_;
    const int ppc = last ? 1 : 2;
    const int nchan = (vcu < 512) ? (512 - vcu + G - 1) / G : 0, np = nchan * ppc;
    if (np == 0) return;
    HyRegs cur, nxt;
    hy_load(cur, P, l, vcu, false, tid);
    for (int p = 0; p < np; ++p) {
        const int c = vcu + G * (p / ppc); const bool isctx = (p % ppc) == 1;
        if (p + 1 < np) hy_load(nxt, P, l, vcu + G * ((p + 1) / ppc), ((p + 1) % ppc) == 1, tid);
        hyena_compute(lds, P, cur, l, c, isctx);
        cur = nxt;
    }
}
__device__ __forceinline__ void pool_unit(PK P, LAS unsigned char* lds, int l, int rb, int g) {
    int tid_ = threadIdx.x; asm volatile("" : "+v"(tid_)); const int tid = tid_, lane = tid & 63, wid = rfl(tid >> 6), tok = lane & 15, kg = lane >> 4;
    const bf16* PL = (const bf16*)(P->ws + WS_PL); bf16* MIXA = (bf16*)(P->ws + WS_MIXA);
    const bf16* PWT = (const bf16*)(P->ws + WS_W + (size_t)l * LW_SIZE + LW_PWT) + (size_t)g * 128 * 128;
    const float* psc = P->in[I_PSCALE] + (size_t)l * PWD + g * 128;
    u32x4 wst[4];
#pragma unroll
    for (int i = 0; i < 4; ++i) wst[i] = *(const u32x4*)(PWT + (size_t)(tid >> 2) * 128 + ((tid & 3) * 4 + i) * 8);
    const int row = rb * 128 + wid * 16 + tok;
    const int sb = (row < RX) ? (row & ~(SEQ - 1)) : (RX + ((row - RX) & ~(CTX - 1))), Ls = (row < RX) ? SEQ : CTX, t = row - sb;
    const int hw = 1 << g;
    const int lo = max(t - hw, 0), hi = min(t + hw, Ls);
    const float invc = 1.f / (float)(hi - lo);
    bf16x8 xf[4];
#pragma unroll
    for (int ks = 0; ks < 4; ++ks) {
        const bf16* cp = PL + (size_t)sb * PWD + g * 128 + 32 * ks + 8 * kg;
        float s[8] = {0.f, 0.f, 0.f, 0.f, 0.f, 0.f, 0.f, 0.f};
        u32x4 c = {0u, 0u, 0u, 0u};
#define PW_LOOP(W) do { u32x4 v_[W]; \
            _Pragma("unroll") for (int q = 0; q < (W); ++q) { const int r_ = t - (W) / 2 + q; const int rc_ = min(max(r_, 0), Ls - 1); v_[q] = *(const u32x4*)(cp + (size_t)rc_ * PWD); } \
            __builtin_amdgcn_sched_barrier(0); \
            _Pragma("unroll") for (int q = 0; q < (W); ++q) { const int r_ = t - (W) / 2 + q; const float f_ = (r_ >= 0 && r_ < Ls) ? 1.f : 0.f; \
                s[0] += f_ * bflo(v_[q].x); s[1] += f_ * bfhi(v_[q].x); s[2] += f_ * bflo(v_[q].y); s[3] += f_ * bfhi(v_[q].y); s[4] += f_ * bflo(v_[q].z); s[5] += f_ * bfhi(v_[q].z); s[6] += f_ * bflo(v_[q].w); s[7] += f_ * bfhi(v_[q].w); } \
            c = v_[(W) / 2]; } while (0)
        if (g == 0) PW_LOOP(2); else if (g == 1) PW_LOOP(4); else if (g == 2) PW_LOOP(8); else PW_LOOP(16);
#undef PW_LOOP
        u32x4 o; o.x = pkbf(s[0] * invc - bflo(c.x), s[1] * invc - bfhi(c.x)); o.y = pkbf(s[2] * invc - bflo(c.y), s[3] * invc - bfhi(c.y));
        o.z = pkbf(s[4] * invc - bflo(c.z), s[5] * invc - bfhi(c.z)); o.w = pkbf(s[6] * invc - bflo(c.w), s[7] * invc - bfhi(c.w));
        xf[ks] = __builtin_bit_cast(bf16x8, o);
    }
#pragma unroll
    for (int i = 0; i < 4; ++i) *(LAS u32x4*)(lds + (tid >> 2) * 272 + ((tid & 3) * 4 + i) * 16) = wst[i];
    __syncthreads();
    f32x4 scv[8];
#pragma unroll
    for (int nbk = 0; nbk < 8; ++nbk) scv[nbk] = *(const f32x4*)(psc + nbk * 16 + 4 * kg);
    __builtin_amdgcn_sched_barrier(0);
#pragma unroll
    for (int nbk = 0; nbk < 8; ++nbk) {
        f32x4 acc = {0.f, 0.f, 0.f, 0.f};
#pragma unroll
        for (int ks = 0; ks < 4; ++ks) { const bf16x8 wf = *(const LAS bf16x8*)(lds + (nbk * 16 + tok) * 272 + (32 * ks + 8 * kg) * 2);
            acc = __builtin_amdgcn_mfma_f32_16x16x32_bf16(wf, xf[ks], acc, 0, 0, 0); }
        const int n0 = nbk * 16 + 4 * kg; const f32x4 sc = scv[nbk];
        u32x2 w; w.x = pkbf(acc[0] * sc.x, acc[1] * sc.y); w.y = pkbf(acc[2] * sc.z, acc[3] * sc.w);
        *(u32x2*)(MIXA + (size_t)row * DM + 1536 + g * 128 + n0) = w;
    }
    __syncthreads();
}

constexpr int NPHASE = 2 + 9 * DEPTH;
constexpr int CV1 = 0, CV2 = 1817, CV3 = 1817, CV4 = 2017;
#ifndef DUPM
#define DUPM 0
#endif
#ifndef DUPB
#define DUPB 0
#endif
__global__ void __launch_bounds__(NTHR, 2) mk_fwd(Params Pv) {
    extern __shared__ __attribute__((aligned(16))) unsigned char lds_raw[];
    LAS unsigned char* lds = (LAS unsigned char*)lds_raw;
    const int G = gridDim.x, bx = blockIdx.x, vcu = (G % 8 == 0) ? (bx % 8) * (G / 8) + bx / 8 : bx;
    const int ph_lo = Pv.ph_lo, ph_hi = Pv.ph_hi;
    if (threadIdx.x < 64) ((LAS unsigned*)(lds + MISC_OFF))[threadIdx.x] = 0u;
    __syncthreads();
    XcdBarrier bar; bar.bar = (unsigned*)(Pv.ws + WS_CTL) + 4096; bar.x = 0; bar.st = nullptr;
    if (ph_hi - ph_lo > 1) bar = xcd_barrier_post((unsigned*)(Pv.ws + WS_CTL) + 4096, (volatile LAS unsigned*)(lds + MISC_OFF) + 8);
#define RUN(p) (ph_lo <= (p) && (p) < ph_hi)
#define SEAM(p) do { if (RUN(p) && RUN((p) + 1)) { xcd_barrier(bar); if (DUPB) xcd_barrier(bar); } } while (0)
#define REP(bit) for (int rep_ = 0; rep_ < (((DUPM) >> (bit)) & 1) + 1; ++rep_)
#define PH_VARS PK P = pk_get(); unsigned char* ws = P->ws; unsigned char* lw = ws + WS_W + (size_t)l * LW_SIZE; const float* ada = (const float*)(ws + WS_ADA) + (size_t)l * 5 * 12288; const float* ng = P->in[I_NORMG] + (size_t)l * 4 * DM; (void)lw; (void)ada; (void)ng

    if (RUN(0)) REP(0) { PK P = pk_get(); prologue_phase(P, lds, vcu, G); __syncthreads(); }
    SEAM(0);
    if (RUN(1)) {
        PK P = pk_get(); const float* ada0 = (const float*)(P->ws + WS_ADA);
        norm_phase<0>(P, vcu, G, RT, ada0, 0, nullptr, nullptr, nullptr, true, ada0, 0, 1, P->in[I_NORMG]);
    }
    SEAM(1);

    for (int l = 0; l < DEPTH; ++l) {
        const int pb = 2 + 9 * l;
        const bool last = (l == DEPTH - 1);
        const int MR = last ? RX : RT;
        if (RUN(pb)) { PH_VARS;
            pg8::Gemm g{(const pg8::bf16_t*)(ws + WS_H), (const pg8::bf16_t*)(lw + LW_WIN), MR, INW, DM, DM, DM};
            OrderX S; S.base.init(MR, INW, G, bx); S.extra = last ? 32 : 0;
            EpiG1 E{(bf16*)(ws + WS_QKV), (bf16*)(ws + WS_HYT), (bf16*)(ws + WS_PL), (bf16*)(ws + WS_GT), (const float*)(ws + WS_ROPE), (const float*)(ws + WS_ROPE) + 1024};
            REP(1) pg8::gemm_phase<EpiG1, OrderX, true, true>(lds, g, S, E);
            if (!last) { const int r = S.base.nwg % G; if (bx >= r) { ada_items(P, lds, l + 1, bx - r, G - r); conv_items(P, lds, l + 1, 0, CV1, bx - r, G - r); } }
        }
        SEAM(pb);
        if (RUN(pb + 1)) { PH_VARS;
            const float* sc = (const float*)(ws + WS_SC) + 2 * l;
            const float lam = sc[0], oscale = sc[1];
            const float* subg = P->in[I_SUBG] + (size_t)l * 128;
            REP(2) for (int u = vcu; u < 512; u += G) attn_unit(lds, (const bf16*)(ws + WS_QKV), (bf16*)(ws + WS_MIXA), lam, oscale, subg, u >> 7, (u >> 4) & 7, u & 15, false);
            REP(3) hyena_parts(lds, P, l, vcu, G, last);
            REP(2) if (!last) for (int u = vcu; u < 64; u += G) attn_unit(lds, (const bf16*)(ws + WS_QKV), (bf16*)(ws + WS_MIXA), lam, oscale, subg, u >> 4, (u >> 1) & 7, u & 1, true);
            const int npool = (MR >> 7) * 4;
            REP(4) for (int u = (vcu + G - 64 % G) % G; u < npool; u += G) pool_unit(P, lds, l, u >> 2, u & 3);
            if (!last) conv_items(P, lds, l + 1, CV4, CONV_ALL, vcu, G);
        }
        SEAM(pb + 1);
        if (RUN(pb + 2)) { PH_VARS; REP(5) {
            pg8::Gemm g{(const pg8::bf16_t*)(ws + WS_MIXA), (const pg8::bf16_t*)(lw + LW_WAO), MR, DM, 512, DM, DM};
            OrderG2 S; S.ctx2 = !last && G == 256; S.base.init(S.ctx2 ? RX : MR, DM, G, bx); if (S.ctx2) S.init2();
            EpiG2 E{(const bf16*)(ws + WS_GT), (bf16*)(ws + WS_MERGED)};
            pg8::gemm_phase<EpiG2, OrderG2, true, true>(lds, g, S, E);
            if (!last) {
                if (S.ctx2) { const int wg = (S.pm0 >> 3) * 64 + S.pn0 * 8 + (S.pm0 & 7);
                    if (S.pm1 < 0) conv_items(P, lds, l + 1, CV1, CV2, wg - (wg >> 3) - 1, 224); }
                else { const int r = S.base.nwg % G; if (bx >= r) conv_items(P, lds, l + 1, CV1, CV2, bx - r, G - r); }
            }
        } }
        SEAM(pb + 2);
        if (RUN(pb + 3)) { PH_VARS; REP(6) {
            pg8::Gemm g{(const pg8::bf16_t*)(ws + WS_MERGED), (const pg8::bf16_t*)(lw + LW_WOUT), RX, DM, DM, DM, DM};
            OrderLatCtx S; S.init(RX, DM, G, bx); S.ctx = !last; S.sp = SplitOrder{128, 4, 512, G, (bx + G / 2) % G};
            EpiPlainSlab E{EpiPlain{(bf16*)(ws + WS_MIX), DM}, EpiSlab{(float*)(ws + WS_SLAB)}};
            pg8::gemm_phase<EpiPlainSlab, OrderLatCtx, true, true>(lds, g, S, E);
        } }
        SEAM(pb + 3);
        if (RUN(pb + 4)) { PH_VARS; norm_phase<1>(P, vcu, G, MR, ada, 2, ng + DM, (const bf16*)(ws + WS_MIX), nullptr, true, ada, 3, 4, ng + 2 * DM, (const float*)(ws + WS_SLAB), last ? 0 : 4); }
        SEAM(pb + 4);
        if (RUN(pb + 5)) { PH_VARS;
            pg8::Gemm g{(const pg8::bf16_t*)(ws + WS_H), (const pg8::bf16_t*)(lw + LW_WUP), MR, INW, DM, DM, DM};
            OrderX S; S.base.init(MR, INW, G, bx); S.extra = 0;
            EpiG4F E{(bf16*)(ws + WS_ACT), (bf16*)(ws + WS_EG), (bf16*)(ws + WS_EV), P->in[I_FFCW] + (size_t)l * 3 * FF};
            REP(7) pg8::gemm_phase<EpiG4F, OrderX, true, true>(lds, g, S, E);
            if (!last) { const int r = S.base.nwg % G; if (bx >= r) { filter_items(P, lds, l + 1, bx - r, G - r); conv_items(P, lds, l + 1, CV2, CV3, bx - r, G - r); } }
        }
        SEAM(pb + 5);
        if (RUN(pb + 6)) REP(8) { PH_VARS; act_edge_phase(P, vcu, G, MR, P->in[I_FFCW] + (size_t)l * 3 * FF); }
        SEAM(pb + 6);
        if (RUN(pb + 7)) { PH_VARS; REP(9) {
            pg8::Gemm g{(const pg8::bf16_t*)(ws + WS_ACT), (const pg8::bf16_t*)(lw + LW_WDN), RX, DM, FF, FF, FF};
            OrderLatCtx S; S.init(RX, DM, G, bx); S.ctx = !last; S.sp = SplitOrder{128, 4, 1408, G, bx};
            EpiPlainSlab E{EpiPlain{(bf16*)(ws + WS_MIX), DM}, EpiSlab{(float*)(ws + WS_SLAB)}};
            pg8::gemm_phase<EpiPlainSlab, OrderLatCtx, true, true>(lds, g, S, E);
            if (!last && bx >= 128) conv_items(P, lds, l + 1, CV3, CV4, bx - 128, G - 128);
        } }
        SEAM(pb + 7);
        if (RUN(pb + 8)) { PH_VARS;
            if (!last) norm_phase<1>(P, vcu, G, RT, ada, 5, ng + 3 * DM, (const bf16*)(ws + WS_MIX), nullptr, true, ada + 5 * 12288, 0, 1, ng + 4 * DM, (const float*)(ws + WS_SLAB), 4);
            else norm_phase<1>(P, vcu, G, RX, ada, 5, ng + 3 * DM, (const bf16*)(ws + WS_MIX), P->out, false, ada, 0, 1, ng);
        }
        if (!last) SEAM(pb + 8);
    }
#undef RUN
#undef SEAM
#undef REP
#undef PH_VARS
}

extern "C" void kernel_launch(void* const* d_in, const int* in_sizes, int n_in, void* d_out, int out_size, void* d_ws, size_t ws_size, hipStream_t stream) {
    static int grid = 0;
    if (grid == 0) {
        if (n_in != 27 || out_size != RX * DM || ws_size < WS_END) { fprintf(stderr, "kernel_launch: unexpected problem shape (n_in %d, out %d, ws %zu < %zu)\n", n_in, out_size, ws_size, (size_t)WS_END); grid = -1; return; }
        int dev = 0, cus = 0;
        if (hipGetDevice(&dev) != hipSuccess || hipDeviceGetAttribute(&cus, hipDeviceAttributeMultiprocessorCount, dev) != hipSuccess || cus <= 0) { grid = -1; return; }
        if (hipFuncSetAttribute((const void*)mk_fwd, hipFuncAttributeMaxDynamicSharedMemorySize, LDS_BYTES) != hipSuccess) { fprintf(stderr, "kernel_launch: hipFuncSetAttribute failed\n"); grid = -1; return; }
        int per_cu = 0;
        if (hipOccupancyMaxActiveBlocksPerMultiprocessor(&per_cu, (const void*)mk_fwd, NTHR, LDS_BYTES) != hipSuccess || per_cu < 1) fprintf(stderr, "kernel_launch: occupancy query reports %d blocks per CU\n", per_cu);
        (void)hipGetLastError();
        grid = cus;
    }
    if (grid < 0) return;
    if (hipMemsetAsync((char*)d_ws + WS_CTL, 0, CTL_ZERO, stream) != hipSuccess) return;
    Params p{};
    for (int i = 0; i < 27; ++i) p.in[i] = (const float*)d_in[i];
    p.out = (float*)d_out; p.ws = (unsigned char*)d_ws;
    p.ph_lo = 0; p.ph_hi = NPHASE;
    hipLaunchKernelGGL(mk_fwd, dim3(grid), dim3(NTHR), LDS_BYTES, stream, p);
}
```

```cpp
#include <hip/hip_runtime.h>
#include <cstdio>
#include <cstdint>
#define GAS __attribute__((address_space(1)))
#define LAS __attribute__((address_space(3)))
typedef unsigned short bf16;
typedef float f32x4 __attribute__((ext_vector_type(4)));
typedef float f32x2 __attribute__((ext_vector_type(2)));
typedef float f32x16 __attribute__((ext_vector_type(16)));
typedef unsigned u32x4 __attribute__((ext_vector_type(4)));
typedef unsigned u32x2 __attribute__((ext_vector_type(2)));
typedef short bf16x8 __attribute__((ext_vector_type(8)));
typedef short s16x4 __attribute__((ext_vector_type(4)));
typedef __bf16 bf16x2_t __attribute__((ext_vector_type(2)));

constexpr int DM = 2048, NBATCH = 4, SEQ = 2048, DEPTH = 4, CTX = 256;
constexpr int RX = NBATCH * SEQ, RC = NBATCH * CTX, RT = RX + RC;
constexpr int INW = 11264, FF = 5632, AW = 1024, HWD = 512, PWD = 512;
constexpr int NQKV = 3072, NGT = 6144;
constexpr float EPS = 1e-6f;
constexpr float QSCALE = 0.125f * 1.4426950408889634f;
constexpr int NWAVES = 8, NTHR = 512;

constexpr size_t al256(size_t x) { return (x + 255) & ~(size_t)255; }
constexpr size_t WS_CTL = 0, CTL_BYTES = 1u << 20, CTL_ZERO = 64u << 10;
constexpr size_t SZ_WIN = (size_t)INW * DM * 2, SZ_WUP = SZ_WIN, SZ_WDN = (size_t)DM * FF * 2, SZ_WOUT = (size_t)DM * DM * 2;
constexpr size_t SZ_WAO = (size_t)DM * AW * 2, SZ_WHO = (size_t)DM * HWD * 2, SZ_WPO = (size_t)DM * PWD * 2, SZ_PWT = 4 * 128 * 128 * 2;
constexpr size_t LW_WIN = 0, LW_WUP = LW_WIN + SZ_WIN, LW_WDN = LW_WUP + SZ_WUP, LW_WOUT = LW_WDN + SZ_WDN, LW_WAO = LW_WOUT + SZ_WOUT,
                 LW_WHO = LW_WAO + SZ_WAO, LW_WPO = LW_WHO + SZ_WHO, LW_PWT = LW_WPO + SZ_WPO, LW_SIZE = LW_PWT + SZ_PWT;
constexpr size_t WS_W = CTL_BYTES;
constexpr size_t WS_ADA = WS_W + DEPTH * LW_SIZE;
constexpr size_t WS_KF = al256(WS_ADA + (size_t)DEPTH * 5 * 12288 * 4);
constexpr size_t WS_KFC = WS_KF + (size_t)DEPTH * 2 * 512 * 4096 * 4;
constexpr size_t WS_ROPE = WS_KFC + (size_t)DEPTH * 2 * 512 * 512 * 4;
constexpr size_t WS_SC = WS_ROPE + 8192;
constexpr size_t WS_XRES = al256(WS_SC + 256);
constexpr size_t WS_H = WS_XRES + (size_t)RT * DM * 4;
constexpr size_t WS_QKV = WS_H + (size_t)RT * DM * 2;
constexpr size_t WS_HYT = WS_QKV + (size_t)RT * NQKV * 2;
constexpr size_t WS_PL = WS_HYT + (size_t)1536 * RT * 2;
constexpr size_t WS_GT = WS_PL + (size_t)RT * 512 * 2;
constexpr size_t WS_UP = WS_QKV;
constexpr size_t WS_EG = WS_UP;
constexpr size_t WS_EV = WS_EG + (size_t)144 * 4 * FF * 2;
constexpr size_t WS_MIXA = WS_GT + (size_t)RT * NGT * 2;
constexpr size_t WS_M32 = WS_MIXA + (size_t)RT * DM * 2;
constexpr size_t WS_MERGED = WS_M32 + (size_t)RT * DM * 4;
constexpr size_t WS_ACT = WS_M32;
constexpr size_t WS_MIX = WS_MERGED + (size_t)RT * DM * 2;
constexpr size_t WS_SLAB = WS_MIX + (size_t)RT * DM * 2;
constexpr size_t WS_END = WS_SLAB + (size_t)8 * RC * DM * 4;
static_assert(WS_UP + (size_t)RT * INW * 2 <= WS_MIXA, "UP overlay");
static_assert(WS_ACT + (size_t)RT * FF * 2 <= WS_MIX, "ACT overlay");

constexpr int MISC_OFF = 147456, LDS_BYTES = MISC_OFF + 256;

__device__ __forceinline__ int rfl(int v) { return __builtin_amdgcn_readfirstlane(v); }
__device__ __forceinline__ unsigned pkbf(float lo, float hi) { f32x2 v = {lo, hi}; bf16x2_t b = __builtin_convertvector(v, bf16x2_t); return __builtin_bit_cast(unsigned, b); }
__device__ __forceinline__ float bflo(unsigned u) { return __uint_as_float(u << 16); }
__device__ __forceinline__ float bfhi(unsigned u) { return __uint_as_float(u & 0xffff0000u); }
__device__ __forceinline__ float wave_sum(float v) {
#pragma unroll
    for (int o = 1; o < 64; o <<= 1) v += __shfl_xor(v, o);
    return v;
}
__device__ __forceinline__ float xhalf_max(float m) { auto rr = __builtin_amdgcn_permlane32_swap(__float_as_uint(m), __float_as_uint(m), false, false); return fmaxf(__uint_as_float(rr[0]), __uint_as_float(rr[1])); }
__device__ __forceinline__ float xhalf_sum(float m) { auto rr = __builtin_amdgcn_permlane32_swap(__float_as_uint(m), __float_as_uint(m), false, false); return __uint_as_float(rr[0]) + __uint_as_float(rr[1]); }
#define LDS_WAIT() asm volatile("s_waitcnt lgkmcnt(0)" ::: "memory")
__device__ __forceinline__ float max3f(float a, float b, float c) { float r; asm("v_max3_f32 %0, %1, %2, %3" : "=v"(r) : "v"(a), "v"(b), "v"(c)); return r; }

struct Params { const float* in[27]; float* out; unsigned char* ws; int ph_lo, ph_hi; };
typedef const __attribute__((address_space(4))) Params* PK;
__device__ __forceinline__ PK pk_get() { PK p = (PK)__builtin_amdgcn_kernarg_segment_ptr(); asm volatile("" : "+s"(p)); return p; }
enum { I_X = 0, I_C, I_CTX, I_CCTX, I_WADA, I_BADA, I_NORMG, I_WIN, I_DLAM, I_SUBG, I_HYSW, I_HW1, I_HB1, I_HW2, I_HB2, I_HW3, I_HFREQ, I_HBIAS,
       I_POOLW, I_PSCALE, I_WAO, I_WHO, I_WPO, I_WOUT, I_WUP, I_FFCW, I_WDN };
namespace pg8 {
#define PG8_LAS __attribute__((address_space(3)))
typedef unsigned short bf16_t;
typedef short bf16x8 __attribute__((ext_vector_type(8)));
typedef float f32x4 __attribute__((ext_vector_type(4)));
typedef unsigned u32x4 __attribute__((ext_vector_type(4)));
constexpr int BM = 256, BK = 64, HALF = 128, HTB = HALF * BK * 2  , STAGE_BYTES = 8 * HTB, NXCD = 8, WGM = 8;

__host__ __device__ __forceinline__ int lds_byte(int r, int c) { const int st = (r >> 4) * 2 + (c >> 5), rr = r & 15, cc = c & 31, ob = rr * 64 + cc * 2; return st * 1024 + (ob ^ (((ob >> 9) & 1) << 5)); }
__host__ __device__ __forceinline__ void stage_rc(int b, int& R, int& C) { const int st = b / 1024, sb = b % 1024, swz = sb ^ (((sb >> 9) & 1) << 5); R = (st >> 1) * 16 + swz / 64; C = (st & 1) * 32 + (swz % 64) / 2; }
__host__ __device__ __forceinline__ int perm32(int rho) { const int n = rho >> 4, i = rho & 15; return 8 * (i >> 2) + 4 * n + (i & 3); }

struct Unit { int pm, pn, ko, ks, kt; };
struct Gemm { const bf16_t* A; const bf16_t* Bt; int M, N, K, lda, ldb; };

struct StaticOrder {
    int nM, nN, nwg, G, c;
    __host__ __device__ void init(int M, int N, int G_, int c_) { nM = M / BM; nN = N / BM; nwg = nM * nN; G = G_; c = c_; }
    __host__ __device__ bool next(int i, Unit& u) const {
        const long L = (long)i * G + c; if (L >= nwg) return false;
        int wgid = (int)L; { const int q = nwg / NXCD, r = nwg % NXCD, xcd = wgid % NXCD, off = wgid / NXCD; wgid = (xcd < r ? xcd * (q + 1) : r * (q + 1) + (xcd - r) * q) + off; }
        const int nig = WGM * nN, gid = wgid / nig, fm = gid * WGM, gsz = (nM - fm) < WGM ? (nM - fm) : WGM;
        u.pm = fm + ((wgid % nig) % gsz); u.pn = (wgid % nig) / gsz; u.ko = 0; u.ks = 0; u.kt = 0; return true;
    }
    __device__ __forceinline__ void a_ready(const Unit&) const {}
    __device__ __forceinline__ void done(const Unit&) const {}
};
__device__ __forceinline__ unsigned cvt_pk_bf16(float lo, float hi) { unsigned r; asm volatile("v_cvt_pk_bf16_f32 %0, %1, %2" : "=v"(r) : "v"(lo), "v"(hi)); return r; }
template <class Epi, class Sched, bool ALIGN_EPI = false, bool SP2 = false>
__device__ __forceinline__ void gemm_phase(PG8_LAS unsigned char* lds, const Gemm g, const Sched& S, const Epi& E) {
    int tid_ = threadIdx.x; asm volatile("" : "+v"(tid_));
    const int tid = tid_, wid = __builtin_amdgcn_readfirstlane(tid >> 6), lane = tid & 63, wr = wid >> 2, wc = wid & 3, fr = lane & 15, fq = lane >> 4;
    const int ntdef = g.K / BK;
    unsigned voffA[2], voffB[2];
#pragma unroll
    for (int i = 0; i < 2; ++i) { int R, C; stage_rc(tid * 16 + i * 8192, R, C); const int Rb = Epi::PERM ? ((R & ~31) + perm32(R & 31)) : R;
        voffA[i] = (unsigned)(R * g.lda + C) * 2u; voffB[i] = (unsigned)(Rb * g.ldb + C) * 2u; }
    const size_t kstep = (size_t)(BK * 2);
    const size_t hstepA = (size_t)HALF * g.lda * 2, hstepB = (size_t)HALF * g.ldb * 2;
    const size_t tstepA = 2 * hstepA, tstepB = 2 * hstepB;
    const unsigned ldsw = (unsigned)wid * 1024u;
    const int aoff = lds_byte(wr * 64 + fr, fq * 8), boff = lds_byte(wc * 32 + fr, fq * 8);
#define PG8_SA(b, h) (((b) * 2 + (h)) * HTB)
#define PG8_SB(b, h) ((4 + (b) * 2 + (h)) * HTB)
#define PG8_STAGE(bufoff, gbase, voff) do { _Pragma("unroll") for (int _i = 0; _i < 2; ++_i) \
        __builtin_amdgcn_global_load_lds((const unsigned*)((const char*)(gbase) + (voff)[_i]), (PG8_LAS unsigned*)(lds + (bufoff) + ldsw + _i * 8192), 16, 0, 0); } while (0)
#define PG8_LDA(dst, b, h) do { _Pragma("unroll") for (int m = 0; m < 4; ++m) _Pragma("unroll") for (int k = 0; k < 2; ++k) dst[m][k] = *(const PG8_LAS bf16x8*)(lds + PG8_SA(b, h) + aoff + m * 2048 + k * 1024); } while (0)
#define PG8_LDB(dst, b, h) do { _Pragma("unroll") for (int n = 0; n < 2; ++n) _Pragma("unroll") for (int k = 0; k < 2; ++k) dst[n][k] = *(const PG8_LAS bf16x8*)(lds + PG8_SB(b, h) + boff + n * 2048 + k * 1024); } while (0)
#define PG8_MMA(ai, bj, At, Bt) do { __builtin_amdgcn_s_setprio(1); _Pragma("unroll") for (int m = 0; m < 4; ++m) _Pragma("unroll") for (int n = 0; n < 2; ++n) _Pragma("unroll") for (int k = 0; k < 2; ++k) \
        acc[ai][bj][m][n] = __builtin_amdgcn_mfma_f32_16x16x32_bf16(Bt[n][k], At[m][k], acc[ai][bj][m][n], 0, 0, 0); __builtin_amdgcn_s_setprio(0); } while (0)
#define PG8_WAIT_V(n) asm volatile("s_waitcnt vmcnt(" #n ")" ::: "memory")
#define PG8_WAIT_L(n) asm volatile("s_waitcnt lgkmcnt(" #n ")" ::: "memory")
#define PG8_BAR __builtin_amdgcn_s_barrier()
#define PG8_SCHED __builtin_amdgcn_sched_barrier(0)
    Unit cur, nxt; int ui = 0;
    if (!S.next(0, cur)) return;
    f32x4 acc[2][2][4][2];
#pragma unroll
    for (int a = 0; a < 2; ++a)
#pragma unroll
        for (int b = 0; b < 2; ++b)
#pragma unroll
            for (int m = 0; m < 4; ++m)
#pragma unroll
                for (int n = 0; n < 2; ++n) acc[a][b][m][n] = (f32x4){0.f, 0.f, 0.f, 0.f};
    bf16x8 At[4][2], B0[2][2], B1[2][2];
    const char* cA = (const char*)g.A + (size_t)cur.pm * tstepA + (size_t)cur.ko * 2; const char* cB = (const char*)g.Bt + (size_t)cur.pn * tstepB + (size_t)cur.ko * 2;
    S.a_ready(cur);
    if constexpr (SP2) {
        PG8_STAGE(PG8_SB(0, 0), cB, voffB); PG8_STAGE(PG8_SB(0, 1), cB + hstepB, voffB); PG8_STAGE(PG8_SA(0, 0), cA, voffA); PG8_STAGE(PG8_SA(0, 1), cA + hstepA, voffA);
        if (wr == 1) PG8_BAR;
        PG8_WAIT_V(2); PG8_BAR;
        PG8_STAGE(PG8_SB(1, 0), cB + kstep, voffB); PG8_STAGE(PG8_SA(1, 0), cA + kstep, voffA); PG8_STAGE(PG8_SB(1, 1), cB + hstepB + kstep, voffB);
        PG8_WAIT_V(6); PG8_BAR;
    } else {
        PG8_STAGE(PG8_SB(0, 0), cB, voffB); PG8_STAGE(PG8_SA(0, 0), cA, voffA); PG8_STAGE(PG8_SB(0, 1), cB + hstepB, voffB); PG8_STAGE(PG8_SA(0, 1), cA + hstepA, voffA);
        if (wr == 1) PG8_BAR;
        PG8_WAIT_V(4); PG8_BAR;
        PG8_STAGE(PG8_SB(1, 0), cB + kstep, voffB); PG8_STAGE(PG8_SA(1, 0), cA + kstep, voffA); PG8_STAGE(PG8_SB(1, 1), cB + hstepB + kstep, voffB);
        PG8_WAIT_V(6); PG8_BAR;
    }
    for (;;) {
        const bool has_next = S.next(ui + 1, nxt);
        const char* nA = has_next ? (const char*)g.A + (size_t)nxt.pm * tstepA + (size_t)nxt.ko * 2 : cA; const char* nB = has_next ? (const char*)g.Bt + (size_t)nxt.pn * tstepB + (size_t)nxt.ko * 2 : cB;
        const int nt = cur.kt ? cur.kt : ntdef;
        for (int t = 0; t < nt; t += 2) {
            const bool last = (t == nt - 2);
            const char* a1 = cA + (size_t)(t + 1) * kstep;
            const char* a2 = last ? nA : cA + (size_t)(t + 2) * kstep; const char* b2 = last ? nB : cB + (size_t)(t + 2) * kstep;
            const char* a3 = a2 + kstep; const char* b3 = b2 + kstep;
            if (last && has_next) S.a_ready(nxt);
            if constexpr (SP2) {
            PG8_LDB(B0, 0, 0); PG8_LDB(B1, 0, 1); PG8_SCHED; PG8_LDA(At, 0, 0); PG8_STAGE(PG8_SA(1, 1), a1 + hstepA, voffA);
            PG8_WAIT_V(8); PG8_WAIT_L(0); PG8_BAR; PG8_MMA(0, 0, At, B0); PG8_MMA(0, 1, At, B1); PG8_BAR; PG8_SCHED;
            PG8_LDA(At, 0, 1); PG8_STAGE(PG8_SB(0, 0), b2, voffB); PG8_STAGE(PG8_SB(0, 1), b2 + hstepB, voffB); PG8_STAGE(PG8_SA(0, 0), a2, voffA);
            PG8_WAIT_V(8); PG8_WAIT_L(0); PG8_BAR; PG8_MMA(1, 0, At, B0); PG8_MMA(1, 1, At, B1); PG8_BAR; PG8_SCHED;
            PG8_LDB(B0, 1, 0); PG8_LDB(B1, 1, 1); PG8_SCHED; PG8_LDA(At, 1, 0); PG8_STAGE(PG8_SA(0, 1), a2 + hstepA, voffA);
            PG8_WAIT_V(8); PG8_WAIT_L(0); PG8_BAR; PG8_MMA(0, 0, At, B0); PG8_MMA(0, 1, At, B1); PG8_BAR; PG8_SCHED;
            PG8_LDA(At, 1, 1); PG8_STAGE(PG8_SB(1, 0), b3, voffB); PG8_STAGE(PG8_SB(1, 1), b3 + hstepB, voffB); PG8_STAGE(PG8_SA(1, 0), a3, voffA);
            PG8_WAIT_V(8); PG8_WAIT_L(0); PG8_BAR; PG8_MMA(1, 0, At, B0); PG8_MMA(1, 1, At, B1); PG8_BAR; PG8_SCHED;
            } else {
            PG8_LDB(B0, 0, 0); PG8_SCHED; PG8_LDA(At, 0, 0); PG8_STAGE(PG8_SA(1, 1), a1 + hstepA, voffA);
            PG8_WAIT_L(8); PG8_BAR; PG8_WAIT_L(0); PG8_MMA(0, 0, At, B0); PG8_BAR; PG8_SCHED;
            PG8_LDB(B1, 0, 1); PG8_STAGE(PG8_SB(0, 0), b2, voffB);
            PG8_BAR; PG8_WAIT_L(0); PG8_MMA(0, 1, At, B1); PG8_BAR;
            PG8_LDA(At, 0, 1); PG8_STAGE(PG8_SA(0, 0), a2, voffA);
            PG8_BAR; PG8_WAIT_L(0); PG8_MMA(1, 0, At, B0); PG8_BAR; PG8_SCHED;
            PG8_STAGE(PG8_SB(0, 1), b2 + hstepB, voffB);
            PG8_WAIT_V(6); PG8_BAR; PG8_MMA(1, 1, At, B1); PG8_BAR;
            PG8_LDB(B0, 1, 0); PG8_SCHED; PG8_LDA(At, 1, 0); PG8_STAGE(PG8_SA(0, 1), a2 + hstepA, voffA);
            PG8_WAIT_L(8); PG8_BAR; PG8_WAIT_L(0); PG8_MMA(0, 0, At, B0); PG8_BAR; PG8_SCHED;
            PG8_LDB(B1, 1, 1); PG8_STAGE(PG8_SB(1, 0), b3, voffB);
            PG8_BAR; PG8_WAIT_L(0); PG8_MMA(0, 1, At, B1); PG8_BAR;
            PG8_LDA(At, 1, 1); PG8_STAGE(PG8_SA(1, 0), a3, voffA);
            PG8_BAR; PG8_WAIT_L(0); PG8_MMA(1, 0, At, B0); PG8_BAR; PG8_SCHED;
            PG8_STAGE(PG8_SB(1, 1), b3 + hstepB, voffB);
            PG8_WAIT_V(6); PG8_BAR; PG8_MMA(1, 1, At, B1); PG8_BAR;
            }
        }
        if constexpr (ALIGN_EPI) { if (wr == 0) PG8_BAR; }
        if constexpr (!Epi::AFTER_DRAIN) { E(acc, cur, wr, wc, fr, fq); S.done(cur); }
        if (!has_next) break;
        if (!E.keep(cur)) {
#pragma unroll
        for (int a = 0; a < 2; ++a)
#pragma unroll
            for (int b = 0; b < 2; ++b)
#pragma unroll
                for (int m = 0; m < 4; ++m)
#pragma unroll
                    for (int n = 0; n < 2; ++n) acc[a][b][m][n] = (f32x4){0.f, 0.f, 0.f, 0.f};
        }
        cur = nxt; cA = nA; cB = nB; ++ui;
        if constexpr (ALIGN_EPI) { if (wr == 1) PG8_BAR; }
    }
    PG8_WAIT_V(0);
    if constexpr (!ALIGN_EPI) { if (wr == 0) PG8_BAR; }
    PG8_BAR;
    if constexpr (Epi::AFTER_DRAIN) { E.fused(acc, cur, wr, wc, fr, fq, lds, wid, lane); S.done(cur); }
#undef PG8_SA
#undef PG8_SB
#undef PG8_STAGE
#undef PG8_LDA
#undef PG8_LDB
#undef PG8_MMA
#undef PG8_WAIT_V
#undef PG8_WAIT_L
#undef PG8_BAR
#undef PG8_SCHED
}
}
#define XB_TMO      128
#define XB_XCNT(j)  (256  + 64 * (j))
#define XB_XSUB(j)  (1280 + 64 * (j))
#define XB_XGEN(j)  (2304 + 64 * (j))
#define XB_TOP      3328
#define XB_TOPGEN   3392
#define XCD_BAR_WORDS 3456
#define XB_SPIN_CAP (1u << 18)

__device__ __forceinline__ unsigned xb_ld(unsigned* p)              { return __hip_atomic_load(p, __ATOMIC_RELAXED, __HIP_MEMORY_SCOPE_AGENT); }
__device__ __forceinline__ unsigned xb_add(unsigned* p, unsigned v) { return __hip_atomic_fetch_add(p, v, __ATOMIC_RELAXED, __HIP_MEMORY_SCOPE_AGENT); }
__device__ __forceinline__ unsigned xb_xcc_id() { return (unsigned)__builtin_amdgcn_s_getreg((3 << 11) | 20) & 0xFu; }
#define XB_SPIN(cond, bar) do { unsigned _sp = 0; while (cond) { __builtin_amdgcn_s_sleep(1); \
    if ((++_sp & 255u) == 0u) { if (xb_ld(&(bar)[XB_TMO])) break; if (_sp > XB_SPIN_CAP) { atomicAdd(&(bar)[XB_TMO], 1u); break; } } } } while (0)

struct XcdBarrier {
    unsigned* bar; unsigned x;
    volatile LAS unsigned* st;
};

__device__ __forceinline__ XcdBarrier xcd_barrier_post(unsigned* bar, volatile LAS unsigned* st) {
    XcdBarrier b; b.bar = bar; b.x = xb_xcc_id(); b.st = st;
    if (threadIdx.x == 0) (void)xb_add(&bar[XB_XCNT(b.x)], 1u);
    return b;
}
__device__ __forceinline__ void xcd_barrier_complete(unsigned* bar, unsigned x, unsigned& nloc, unsigned& nx) {
    const unsigned G = gridDim.x * gridDim.y * gridDim.z;
    unsigned sum, cnt, mine, sp = 0u;
    for (;;) {
        sum = 0u; cnt = 0u; mine = 0u;
        unsigned c16[16];
#pragma unroll
        for (unsigned j = 0; j < 16; ++j) c16[j] = xb_ld(&bar[XB_XCNT(j)]);
        __builtin_amdgcn_sched_barrier(0);
#pragma unroll
        for (unsigned j = 0; j < 16; ++j) { const unsigned c = c16[j]; sum += c; cnt += (c > 0u) ? 1u : 0u; mine = (j == x) ? c : mine; }
        if (sum == G) break;
        __builtin_amdgcn_s_sleep(1);
        if ((++sp & 255u) == 0u) { if (xb_ld(&bar[XB_TMO])) break; if (sp > XB_SPIN_CAP) { atomicAdd(&bar[XB_TMO], 1u); break; } }
    }
    nloc = mine > 0u ? mine : 1u; nx = cnt > 0u ? cnt : 1u;
}

__device__ __forceinline__ void xcd_barrier(const XcdBarrier& b) {
    asm volatile("s_waitcnt vmcnt(0)" ::: "memory");
    __syncthreads();
    if (threadIdx.x == 0) {
        unsigned* bar = b.bar;
        __builtin_amdgcn_s_waitcnt(0);
        unsigned nloc = b.st[0], nx = b.st[1];
        if (nloc == 0u) { xcd_barrier_complete(bar, b.x, nloc, nx); b.st[0] = nloc; b.st[1] = nx; }
        const unsigned old = xb_add(&bar[XB_XSUB(b.x)], 1u);
        const unsigned gen = old / nloc;
        if (old + 1u == (gen + 1u) * nloc) {
            __builtin_amdgcn_fence(__ATOMIC_RELEASE, "agent");
            asm volatile("s_waitcnt vmcnt(0)" ::: "memory");
            const unsigned og = xb_add(&bar[XB_TOP], 1u);
            const unsigned tg = og / nx;
            if (og + 1u == (tg + 1u) * nx) xb_add(&bar[XB_TOPGEN], 1u);
            else XB_SPIN(xb_ld(&bar[XB_TOPGEN]) == tg, bar);
            __builtin_amdgcn_fence(__ATOMIC_ACQUIRE, "agent");
            xb_add(&bar[XB_XGEN(b.x)], 1u);
            asm volatile("s_waitcnt vmcnt(0)" ::: "memory");
        } else {
            XB_SPIN(xb_ld(&bar[XB_XGEN(b.x)]) == gen, bar);
            __builtin_amdgcn_fence(__ATOMIC_ACQUIRE, "agent");
            asm volatile("s_waitcnt vmcnt(0)" ::: "memory");
        }
    }
    __syncthreads();
}
struct OrderX {
    pg8::StaticOrder base; int extra;
    __device__ __forceinline__ bool next(int i, pg8::Unit& u) const {
        long L = (long)i * base.G + base.c;
        if (L < base.nwg) return base.next(i, u);
        L -= base.nwg; if (L >= extra) return false;
        u.pm = 32 + (int)(L >> 3); u.pn = 4 + (int)(L & 7); u.ko = 0; u.ks = 0; u.kt = 0; return true;
    }
    __device__ __forceinline__ void a_ready(const pg8::Unit&) const {}
    __device__ __forceinline__ void done(const pg8::Unit&) const {}
};

struct EpiPlain {
    static constexpr bool PERM = true, AFTER_DRAIN = false; __device__ __forceinline__ bool keep(const pg8::Unit&) const { return false; }
    bf16* O; int ldc;
    __device__ __forceinline__ void operator()(const f32x4 (&acc)[2][2][4][2], const pg8::Unit& u, int wr, int wc, int fr, int fq) const {
        const int row0 = u.pm * 256 + wr * 64 + fr, col0 = u.pn * 256 + wc * 32 + 8 * fq;
#pragma unroll
        for (int ai = 0; ai < 2; ++ai)
#pragma unroll
            for (int m = 0; m < 4; ++m) { bf16* rowp = O + (size_t)(row0 + ai * 128 + m * 16) * ldc + col0;
#pragma unroll
                for (int bj = 0; bj < 2; ++bj) { const f32x4 v0 = acc[ai][bj][m][0], v1 = acc[ai][bj][m][1];
                    u32x4 w; w.x = pkbf(v0[0], v0[1]); w.y = pkbf(v0[2], v0[3]); w.z = pkbf(v1[0], v1[1]); w.w = pkbf(v1[2], v1[3]);
                    *(u32x4*)(rowp + bj * 128) = w; } }
    }
};

struct EpiG1 {
    static constexpr bool PERM = true, AFTER_DRAIN = false; __device__ __forceinline__ bool keep(const pg8::Unit&) const { return false; }
    bf16* QKV; bf16* HYT; bf16* PL; bf16* GT; const float* ropeC; const float* ropeS;
    __device__ __forceinline__ void operator()(const f32x4 (&acc)[2][2][4][2], const pg8::Unit& u, int wr, int wc, int fr, int fq) const {
        const int pn = u.pn, pm = u.pm;
        const int row0 = pm * 256 + wr * 64 + fr;
        if (pn < 12) {
            const bool rope = (pn < 8) && (pm < 32);
            const float sc = (pn < 4) ? QSCALE : 1.f;
            const int col0 = pn * 256 + wc * 32 + 8 * fq;
#pragma unroll
            for (int ai = 0; ai < 2; ++ai) {
                f32x4 csv[4], snv[4];
#pragma unroll
                for (int m = 0; m < 4; ++m) { csv[m] = (f32x4){1.f, 1.f, 1.f, 1.f}; snv[m] = (f32x4){0.f, 0.f, 0.f, 0.f};
                    if (rope) { const int t = (row0 + ai * 128 + m * 16) & (SEQ - 1); const int pos = (wc & 1) ? (t & 63) : (t >> 6);
                        csv[m] = *(const f32x4*)(ropeC + pos * 16 + 4 * fq); snv[m] = *(const f32x4*)(ropeS + pos * 16 + 4 * fq); } }
                __builtin_amdgcn_sched_barrier(0);
#pragma unroll
                for (int m = 0; m < 4; ++m) {
                    const int row = row0 + ai * 128 + m * 16;
                    const f32x4 cs = csv[m], sn = snv[m];
                    bf16* rowp = QKV + (size_t)row * NQKV + col0;
#pragma unroll
                    for (int bj = 0; bj < 2; ++bj) { const f32x4 v0 = acc[ai][bj][m][0], v1 = acc[ai][bj][m][1];
                        float o0 = v0[0] * cs[0] - v0[1] * sn[0], o1 = v0[1] * cs[0] + v0[0] * sn[0];
                        float o2 = v0[2] * cs[1] - v0[3] * sn[1], o3 = v0[3] * cs[1] + v0[2] * sn[1];
                        float o4 = v1[0] * cs[2] - v1[1] * sn[2], o5 = v1[1] * cs[2] + v1[0] * sn[2];
                        float o6 = v1[2] * cs[3] - v1[3] * sn[3], o7 = v1[3] * cs[3] + v1[2] * sn[3];
                        u32x4 w; w.x = pkbf(o0 * sc, o1 * sc); w.y = pkbf(o2 * sc, o3 * sc); w.z = pkbf(o4 * sc, o5 * sc); w.w = pkbf(o6 * sc, o7 * sc);
                        *(u32x4*)(rowp + bj * 128) = w; }
                }
            }
        } else if (pn < 18) {
            const int ch0 = (pn - 12) * 256 + wc * 32 + 8 * fq;
            const int odd = fr & 1;
#pragma unroll
            for (int ai = 0; ai < 2; ++ai)
#pragma unroll
                for (int m = 0; m < 4; ++m) {
                    const int row = row0 + ai * 128 + m * 16;
#pragma unroll
                    for (int bj = 0; bj < 2; ++bj) { const f32x4 v0 = acc[ai][bj][m][0], v1 = acc[ai][bj][m][1];
                        unsigned pk[4] = {pkbf(v0[0], v0[1]), pkbf(v0[2], v0[3]), pkbf(v1[0], v1[1]), pkbf(v1[2], v1[3])};
#pragma unroll
                        for (int j = 0; j < 4; ++j) { const unsigned nb = (unsigned)__shfl_xor((int)pk[j], 1);
                            const unsigned o = odd ? ((nb >> 16) | (pk[j] & 0xffff0000u)) : ((pk[j] & 0xffffu) | (nb << 16));
                            const int ch = ch0 + bj * 128 + 2 * j + odd;
                            *(unsigned*)(HYT + (size_t)ch * RT + (row - odd)) = o; }
                    }
                }
        } else if (pn < 20) {
            const int col0 = (pn - 18) * 256 + wc * 32 + 8 * fq;
#pragma unroll
            for (int ai = 0; ai < 2; ++ai)
#pragma unroll
                for (int m = 0; m < 4; ++m) { bf16* rowp = PL + (size_t)(row0 + ai * 128 + m * 16) * PWD + col0;
#pragma unroll
                    for (int bj = 0; bj < 2; ++bj) { const f32x4 v0 = acc[ai][bj][m][0], v1 = acc[ai][bj][m][1];
                        u32x4 w; w.x = pkbf(v0[0], v0[1]); w.y = pkbf(v0[2], v0[3]); w.z = pkbf(v1[0], v1[1]); w.w = pkbf(v1[2], v1[3]);
                        *(u32x4*)(rowp + bj * 128) = w; } }
        } else {
            const int col0 = (pn - 20) * 256 + wc * 32 + 8 * fq;
#pragma unroll
            for (int ai = 0; ai < 2; ++ai)
#pragma unroll
                for (int m = 0; m < 4; ++m) { bf16* rowp = GT + (size_t)(row0 + ai * 128 + m * 16) * NGT + col0;
#pragma unroll
                    for (int bj = 0; bj < 2; ++bj) { const f32x4 v0 = acc[ai][bj][m][0], v1 = acc[ai][bj][m][1];
                        float s[8];
#pragma unroll
                        for (int i = 0; i < 4; ++i) { s[i] = __builtin_amdgcn_rcpf(1.f + __builtin_amdgcn_exp2f(-1.4426950408889634f * v0[i])); s[4 + i] = __builtin_amdgcn_rcpf(1.f + __builtin_amdgcn_exp2f(-1.4426950408889634f * v1[i])); }
                        u32x4 w; w.x = pkbf(s[0], s[1]); w.y = pkbf(s[2], s[3]); w.z = pkbf(s[4], s[5]); w.w = pkbf(s[6], s[7]);
                        *(u32x4*)(rowp + bj * 128) = w; } }
        }
    }
};

struct EpiG2 {
    static constexpr bool PERM = true, AFTER_DRAIN = false;
    const bf16* GT; bf16* MERGED;
    __device__ __forceinline__ bool keep(const pg8::Unit& u) const { return u.ks < 3; }
    __device__ __forceinline__ void operator()(f32x4 (&acc)[2][2][4][2], const pg8::Unit& u, int wr, int wc, int fr, int fq) const {
        if (u.ks == 0) return;
        const int seg = u.ks - 1;
        int lane_; asm volatile("v_mbcnt_lo_u32_b32 %0, -1, 0\n\tv_mbcnt_hi_u32_b32 %0, -1, %0" : "=v"(lane_));
        const int fr_ = lane_ & 15, fq_ = lane_ >> 4; (void)fr; (void)fq;
        const int row0 = u.pm * 256 + wr * 64 + fr_, col0 = u.pn * 256 + wc * 32 + 8 * fq_;
        const float eps = 1e-30f;
        if (seg < 2) {
#pragma unroll
            for (int h = 0; h < 4; ++h) { const int ai = h >> 1, bj = h & 1; const int col = col0 + bj * 128;
                u32x4 gn[4], gd[4];
#pragma unroll
                for (int m = 0; m < 4; ++m) { const size_t row = (size_t)(row0 + ai * 128 + m * 16);
                    gn[m] = *(const u32x4*)(GT + row * NGT + seg * DM + col); gd[m] = *(const u32x4*)(GT + row * NGT + (seg + 1) * DM + col); }
                __builtin_amdgcn_sched_barrier(0);
#pragma unroll
                for (int m = 0; m < 4; ++m) {
                    f32x4 f0 = {fmaxf(bflo(gn[m].x), eps) * __builtin_amdgcn_rcpf(fmaxf(bflo(gd[m].x), eps)), fmaxf(bfhi(gn[m].x), eps) * __builtin_amdgcn_rcpf(fmaxf(bfhi(gd[m].x), eps)),
                                fmaxf(bflo(gn[m].y), eps) * __builtin_amdgcn_rcpf(fmaxf(bflo(gd[m].y), eps)), fmaxf(bfhi(gn[m].y), eps) * __builtin_amdgcn_rcpf(fmaxf(bfhi(gd[m].y), eps))};
                    f32x4 f1 = {fmaxf(bflo(gn[m].z), eps) * __builtin_amdgcn_rcpf(fmaxf(bflo(gd[m].z), eps)), fmaxf(bfhi(gn[m].z), eps) * __builtin_amdgcn_rcpf(fmaxf(bfhi(gd[m].z), eps)),
                                fmaxf(bflo(gn[m].w), eps) * __builtin_amdgcn_rcpf(fmaxf(bflo(gd[m].w), eps)), fmaxf(bfhi(gn[m].w), eps) * __builtin_amdgcn_rcpf(fmaxf(bfhi(gd[m].w), eps))};
                    acc[ai][bj][m][0] *= f0; acc[ai][bj][m][1] *= f1; }
                __builtin_amdgcn_sched_barrier(0);
            }
        } else {
#pragma unroll
            for (int h = 0; h < 4; ++h) { const int ai = h >> 1, bj = h & 1; const int col = col0 + bj * 128;
                u32x4 gn[4];
#pragma unroll
                for (int m = 0; m < 4; ++m) { const size_t row = (size_t)(row0 + ai * 128 + m * 16); gn[m] = *(const u32x4*)(GT + row * NGT + 2 * DM + col); }
                __builtin_amdgcn_sched_barrier(0);
#pragma unroll
                for (int m = 0; m < 4; ++m) { const size_t row = (size_t)(row0 + ai * 128 + m * 16);
                    const f32x4 v0 = acc[ai][bj][m][0], v1 = acc[ai][bj][m][1];
                    f32x4 a0 = {v0[0] * fmaxf(bflo(gn[m].x), eps), v0[1] * fmaxf(bfhi(gn[m].x), eps), v0[2] * fmaxf(bflo(gn[m].y), eps), v0[3] * fmaxf(bfhi(gn[m].y), eps)};
                    f32x4 a1 = {v1[0] * fmaxf(bflo(gn[m].z), eps), v1[1] * fmaxf(bfhi(gn[m].z), eps), v1[2] * fmaxf(bflo(gn[m].w), eps), v1[3] * fmaxf(bfhi(gn[m].w), eps)};
                    u32x4 w; w.x = pkbf(a0[0], a0[1]); w.y = pkbf(a0[2], a0[3]); w.z = pkbf(a1[0], a1[1]); w.w = pkbf(a1[2], a1[3]);
                    *(u32x4*)(MERGED + row * DM + col) = w; }
                __builtin_amdgcn_sched_barrier(0);
            }
        }
    }
};
struct OrderG2 {
    pg8::StaticOrder base; bool ctx2 = false; int pm0 = 0, pn0 = 0, pm1 = -1;
    __device__ __forceinline__ void init2() { pg8::Unit f; base.next(0, f); pm0 = f.pm; pn0 = f.pn; pm1 = (f.pm & 7) ? -1 : 32 + (f.pm >> 3); }
    __device__ __forceinline__ bool next(int i, pg8::Unit& u) const {
        const int t = i >> 2;
        if (!ctx2) { if (!base.next(t, u)) return false; }
        else { if (t > 1 || (t == 1 && pm1 < 0)) return false; u.pm = t ? pm1 : pm0; u.pn = pn0; }
        u.ks = i & 3; u.ko = 512 * (i & 3); u.kt = 0; return true; }
    __device__ __forceinline__ void a_ready(const pg8::Unit&) const {}
    __device__ __forceinline__ void done(const pg8::Unit&) const {}
};

struct SplitOrder {
    int nsub, S, kslice, G, c;
    __device__ __forceinline__ bool next(int i, pg8::Unit& u) const {
        const int j = i * G + c; if (j >= nsub) return false;
        const int tile = j / S, ks = j - tile * S; u.pm = 32 + (tile >> 3); u.pn = tile & 7; u.ko = ks * kslice; u.ks = ks; u.kt = kslice >> 6; return true;
    }
    __device__ __forceinline__ void a_ready(const pg8::Unit&) const {}
    __device__ __forceinline__ void done(const pg8::Unit&) const {}
};
struct EpiSlab {
    static constexpr bool PERM = true, AFTER_DRAIN = false; __device__ __forceinline__ bool keep(const pg8::Unit&) const { return false; }
    float* SLAB;
    __device__ __forceinline__ void operator()(const f32x4 (&acc)[2][2][4][2], const pg8::Unit& u, int wr, int wc, int fr, int fq) const {
        const int row0 = (u.pm - 32) * 256 + wr * 64 + fr, col0 = u.pn * 256 + wc * 32 + 8 * fq;
        bf16* base = (bf16*)SLAB + (size_t)u.ks * RC * DM;
#pragma unroll
        for (int ai = 0; ai < 2; ++ai)
#pragma unroll
            for (int m = 0; m < 4; ++m) { bf16* rowp = base + (size_t)(row0 + ai * 128 + m * 16) * DM + col0;
#pragma unroll
                for (int bj = 0; bj < 2; ++bj) { const f32x4 v0 = acc[ai][bj][m][0], v1 = acc[ai][bj][m][1];
                    u32x4 w; w.x = pkbf(v0[0], v0[1]); w.y = pkbf(v0[2], v0[3]); w.z = pkbf(v1[0], v1[1]); w.w = pkbf(v1[2], v1[3]);
                    *(u32x4*)(rowp + bj * 128) = w; } }
    }
};

template <int CTRL> __device__ __forceinline__ float dppf(float x) { return __builtin_bit_cast(float, __builtin_amdgcn_update_dpp(0, __builtin_bit_cast(int, x), CTRL, 0xf, 0xf, true)); }
__device__ __forceinline__ float gelu_tanh_f(float a) { constexpr float GC1 = -2.f * 1.4426950408889634f * 0.7978845608028654f, GC2 = GC1 * 0.044715f;
    const float p = __builtin_fmaf(GC2, a * a, GC1); return a * __builtin_amdgcn_rcpf(1.f + __builtin_amdgcn_exp2f(a * p)); }
struct OrderLatCtx {
    pg8::StaticOrder base; SplitOrder sp; int nlat; bool ctx;
    __device__ __forceinline__ void init(int M, int N, int G, int c) { base.init(M, N, G, c); nlat = c < base.nwg ? (base.nwg - c + G - 1) / G : 0; }
    __device__ __forceinline__ bool next(int i, pg8::Unit& u) const { if (i < nlat) return base.next(i, u); return ctx && sp.next(i - nlat, u); }
    __device__ __forceinline__ void a_ready(const pg8::Unit&) const {}
    __device__ __forceinline__ void done(const pg8::Unit&) const {}
};
struct EpiPlainSlab {
    static constexpr bool PERM = true, AFTER_DRAIN = false; __device__ __forceinline__ bool keep(const pg8::Unit&) const { return false; }
    EpiPlain a; EpiSlab b;
    __device__ __forceinline__ void operator()(const f32x4 (&acc)[2][2][4][2], const pg8::Unit& u, int wr, int wc, int fr, int fq) const { if (u.pm >= 32) b(acc, u, wr, wc, fr, fq); else a(acc, u, wr, wc, fr, fq); }
};
struct EpiG4F {
    static constexpr bool PERM = true, AFTER_DRAIN = false; __device__ __forceinline__ bool keep(const pg8::Unit&) const { return false; }
    bf16* ACT; bf16* EG; bf16* EV; const float* cw;
    __device__ __forceinline__ void operator()(const f32x4 (&acc)[2][2][4][2], const pg8::Unit& u, int wr, int wc, int fr, int fq) const {
        const int ch0 = u.pn * 128 + wc * 32 + 8 * fq;
        float w0[8], w1[8], w2[8];
#pragma unroll
        for (int i = 0; i < 8; i += 4) { *(f32x4*)(w0 + i) = *(const f32x4*)(cw + ch0 + i); *(f32x4*)(w1 + i) = *(const f32x4*)(cw + FF + ch0 + i); *(f32x4*)(w2 + i) = *(const f32x4*)(cw + 2 * FF + ch0 + i); }
#pragma unroll
        for (int ai = 0; ai < 2; ++ai) {
            const int brow = u.pm * 256 + ai * 128 + wr * 64, blk = brow >> 6;
#pragma unroll
            for (int m = 0; m < 4; ++m) {
                const int row = brow + 16 * m + fr;
                float o[8];
#pragma unroll
                for (int e = 0; e < 8; ++e) {
                    const float gc = acc[ai][0][m][e >> 2][e & 3];
                    const float gp = (m > 0) ? acc[ai][0][m > 0 ? m - 1 : 0][e >> 2][e & 3] : gc, gn = (m < 3) ? acc[ai][0][m < 3 ? m + 1 : 3][e >> 2][e & 3] : gc;
                    const float up = dppf<0x121>((fr == 15) ? gp : gc), dn = dppf<0x12F>((fr == 0) ? gn : gc);
                    o[e] = gelu_tanh_f(w0[e] * up + w1[e] * gc + w2[e] * dn) * acc[ai][1][m][e >> 2][e & 3];
                }
                const bool first = (m == 0 && fr == 0), lastr = (m == 3 && fr == 15);
                if (!first && !lastr) { u32x4 w; w.x = pkbf(o[0], o[1]); w.y = pkbf(o[2], o[3]); w.z = pkbf(o[4], o[5]); w.w = pkbf(o[6], o[7]); *(u32x4*)(ACT + (size_t)row * FF + ch0) = w; }
                if ((m == 0 && fr < 2) || (m == 3 && fr > 13)) {
                    const f32x4 g0 = acc[ai][0][m][0], g1 = acc[ai][0][m][1];
                    u32x4 w; w.x = pkbf(g0[0], g0[1]); w.y = pkbf(g0[2], g0[3]); w.z = pkbf(g1[0], g1[1]); w.w = pkbf(g1[2], g1[3]);
                    const int slot = (m == 0) ? fr : fr - 12;
                    *(u32x4*)(EG + ((size_t)blk * 4 + slot) * FF + ch0) = w;
                    if (first || lastr) { const f32x4 v0 = acc[ai][1][m][0], v1 = acc[ai][1][m][1];
                        u32x4 x; x.x = pkbf(v0[0], v0[1]); x.y = pkbf(v0[2], v0[3]); x.z = pkbf(v1[0], v1[1]); x.w = pkbf(v1[2], v1[3]);
                        *(u32x4*)(EV + ((size_t)blk * 2 + (first ? 0 : 1)) * FF + ch0) = x; }
                }
            }
        }
    }
};
__device__ __forceinline__ void transpose_item(const float* __restrict__ W, int K, int N, bf16* __restrict__ WT, int item, int nperm, LAS float* scr, int lane) {
    const int nblk = N >> 6, kb = item / nblk, nb = item - kb * nblk, k0 = kb * 64, n0 = nb * 64;
    f32x4 v[16];
    const float* src = W + (size_t)(k0 + (lane >> 4)) * N + n0 + (lane & 15) * 4;
#pragma unroll
    for (int i = 0; i < 16; ++i) v[i] = *(const f32x4*)(src + (size_t)(4 * i) * N);
    __builtin_amdgcn_sched_barrier(0);
#pragma unroll
    for (int i = 0; i < 16; ++i) *(LAS f32x4*)(scr + (4 * i + (lane >> 4)) * 68 + (lane & 15) * 4) = v[i];
    LDS_WAIT();
    const int c = lane & 7;
#pragma unroll
    for (int j = 0; j < 8; ++j) { const int n = (lane >> 3) + 8 * j; const LAS float* s = scr + (8 * c) * 68 + n;
        u32x4 o; o.x = pkbf(s[0], s[68]); o.y = pkbf(s[2 * 68], s[3 * 68]); o.z = pkbf(s[4 * 68], s[5 * 68]); o.w = pkbf(s[6 * 68], s[7 * 68]);
        int nd = n; if (n0 < nperm) nd = 2 * (16 * (n >> 5) + (n & 15)) + ((n >> 4) & 1);
        *(u32x4*)(WT + (size_t)(n0 + nd) * K + k0 + 8 * c) = o; }
    LDS_WAIT();
}

__device__ __forceinline__ void transpose_wg_item(const float* __restrict__ W, int K, int N, bf16* __restrict__ WT, int item, int mode  , LAS float* scr, int tid, int ldk, int koff  ) {
    const int nblk = N >> 7, kb = item / nblk, nb = item - kb * nblk, k0 = kb * 256, n0 = nb * 128;
    f32x4 v[16];
    const int kr = tid >> 5, n4 = (tid & 31) * 4;
    const float* src = W + (size_t)(k0 + kr) * N + n0 + n4;
#pragma unroll
    for (int i = 0; i < 16; ++i) v[i] = __builtin_nontemporal_load((const f32x4*)(src + (size_t)(16 * i) * N));
    __builtin_amdgcn_sched_barrier(0);
#pragma unroll
    for (int i = 0; i < 16; ++i) { const int k = 16 * i + kr; *(LAS f32x4*)(scr + k * 132 + (n4 ^ (((k >> 3) & 7) << 2))) = v[i]; }
    __syncthreads();
    const int c = tid & 31;
#pragma unroll
    for (int j = 0; j < 8; ++j) { const int n = (tid >> 5) + 16 * j; const LAS float* s = scr + (8 * c) * 132 + (n ^ ((c & 7) << 2));
        u32x4 o; o.x = pkbf(s[0], s[132]); o.y = pkbf(s[2 * 132], s[3 * 132]); o.z = pkbf(s[4 * 132], s[5 * 132]); o.w = pkbf(s[6 * 132], s[7 * 132]);
        int nd = n0 + n;
        if (mode == 1 && n0 < 2048) { const int d = n & 63; nd = n0 + (n & 64) + 2 * (16 * (d >> 5) + (d & 15)) + ((d >> 4) & 1); }
        if (mode == 2) nd = ((n0 % FF) >> 7) * 256 + (n0 >= FF ? 128 : 0) + n;
        __builtin_nontemporal_store(o, (u32x4*)(WT + (size_t)nd * ldk + koff + k0 + 8 * c)); }
    __syncthreads();
}

__device__ __forceinline__ void ada_items(PK P, LAS unsigned char* lds, int l, int widx, int nw) {
    int tid_ = threadIdx.x; asm volatile("" : "+v"(tid_)); const int tid = tid_;
    LAS float* sil = (LAS float*)lds;
    LAS float* red = (LAS float*)(lds + 40960);
    for (int i = tid; i < 5 * DM; i += NTHR) { const float x = (i < 4 * DM) ? P->in[I_C][i] : P->in[I_CCTX][i - 4 * DM]; sil[i] = x / (1.f + __expf(-x)); }
    __syncthreads();
    float* ADA = (float*)(P->ws + WS_ADA);
    const int kg = tid >> 4, n4 = (tid & 15) * 4;
    for (int it = widx; it < 192; it += nw) {
        const int n0 = it * 64;
        const float* wp = P->in[I_WADA] + ((size_t)l * DM + kg) * 12288 + n0 + n4;
        f32x4 a[5];
#pragma unroll
        for (int r = 0; r < 5; ++r) a[r] = (f32x4){0.f, 0.f, 0.f, 0.f};
#pragma unroll 1
        for (int kk0 = 0; kk0 < 64; kk0 += 8) {
            f32x4 w[8];
#pragma unroll
            for (int j = 0; j < 8; ++j) w[j] = __builtin_nontemporal_load((const f32x4*)(wp + (size_t)(32 * (kk0 + j)) * 12288));
            __builtin_amdgcn_sched_barrier(0);
#pragma unroll
            for (int j = 0; j < 8; ++j) { const int k = kg + 32 * (kk0 + j);
#pragma unroll
                for (int r = 0; r < 5; ++r) a[r] += w[j] * sil[r * DM + k]; }
            __builtin_amdgcn_sched_barrier(0);
        }
#pragma unroll
        for (int r = 0; r < 5; ++r) *(LAS f32x4*)(red + (kg * 5 + r) * 64 + n4) = a[r];
        __syncthreads();
        if (tid < 320) { const int r = tid >> 6, n = tid & 63; float s = 0.f;
#pragma unroll 8
            for (int g = 0; g < 32; ++g) s += red[(g * 5 + r) * 64 + n];
            ADA[((size_t)l * 5 + r) * 12288 + n0 + n] = s + P->in[I_BADA][(size_t)l * 12288 + n0 + n]; }
        __syncthreads();
    }
}
__device__ __forceinline__ void filter_items(PK P, LAS unsigned char* lds, int l, int widx, int nw) {
    int tid_ = threadIdx.x; asm volatile("" : "+v"(tid_)); const int tid = tid_;
    unsigned char* ws = P->ws;
    LAS float* zs = (LAS float*)lds;
    LAS float* h1s = (LAS float*)(lds + 8192);
    LAS float* h2s = (LAS float*)(lds + 16384);
    LAS float* w1s = (LAS float*)(lds + 24576);
    LAS float* w2s = (LAS float*)(lds + 36864);
    const int NI = 256 + ((l < DEPTH - 1) ? 32 : 0);
    __syncthreads();
    if (widx < NI) {
        const float* w1 = P->in[I_HW1] + (size_t)l * 33 * 64; const float* w2 = P->in[I_HW2] + (size_t)l * 64 * 64;
        for (int i = tid; i < 33 * 16; i += NTHR) *(LAS f32x4*)(w1s + 4 * i) = *(const f32x4*)(w1 + 4 * i);
        for (int i = tid; i < 64 * 16; i += NTHR) *(LAS f32x4*)(w2s + 4 * i) = *(const f32x4*)(w2 + 4 * i);
    }
    __syncthreads();
    for (int it = widx; it < NI; it += nw) {
        int lag0, combo, L;
        if (it < 256) { lag0 = (it >> 2) * 32; combo = it & 3; L = SEQ; }
        else { const int j = it - 256; lag0 = (j >> 2) * 32; combo = j & 3; L = CTX; }
        { const int li = tid >> 4, j = tid & 15; const float lagf = (float)(lag0 + li);
          const float wang = 6.283185307179586f * lagf / (float)L; const float f = 1e-4f + (float)j * ((15.f - 1e-4f) / 15.f);
          zs[li * 36 + 1 + j] = cosf(f * wang); zs[li * 36 + 17 + j] = -sinf(f * wang); if (j == 0) zs[li * 36] = lagf / (float)(L - 1); }
        __syncthreads();
        { const int li = tid >> 4, u0 = (tid & 15) * 4; f32x4 s = *(const f32x4*)(P->in[I_HB1] + l * 64 + u0);
#pragma unroll 3
          for (int k = 0; k < 33; ++k) s += *(const LAS f32x4*)(w1s + k * 64 + u0) * zs[li * 36 + k];
          const f32x4 fr = *(const f32x4*)(P->in[I_HFREQ] + l * 128 + u0);
          f32x4 o; o.x = sinf(fr.x * s.x); o.y = sinf(fr.y * s.y); o.z = sinf(fr.z * s.z); o.w = sinf(fr.w * s.w); *(LAS f32x4*)(h1s + li * 64 + u0) = o; }
        __syncthreads();
        { const int li = tid >> 4, u0 = (tid & 15) * 4; f32x4 s = *(const f32x4*)(P->in[I_HB2] + l * 64 + u0);
#pragma unroll 4
          for (int k = 0; k < 64; ++k) s += *(const LAS f32x4*)(w2s + k * 64 + u0) * h1s[li * 64 + k];
          const f32x4 fr = *(const f32x4*)(P->in[I_HFREQ] + l * 128 + 64 + u0);
          f32x4 o; o.x = sinf(fr.x * s.x); o.y = sinf(fr.y * s.y); o.z = sinf(fr.z * s.z); o.w = sinf(fr.w * s.w); *(LAS f32x4*)(h2s + li * 64 + u0) = o; }
        __syncthreads();
        {
            const int lane = tid & 63, wv = tid >> 6, r32 = lane & 31, hh = lane >> 5, dir = combo >> 1, o = combo & 1;
            bf16x8 ah[4], al[4];
#pragma unroll
            for (int ks = 0; ks < 4; ++ks) { const LAS float* hp = h2s + r32 * 64 + 16 * ks + 8 * hh; const f32x4 x0 = *(const LAS f32x4*)hp, x1 = *(const LAS f32x4*)(hp + 4);
                const float xv[8] = {x0.x, x0.y, x0.z, x0.w, x1.x, x1.y, x1.z, x1.w}; u32x4 hi4, lo4;
#pragma unroll
                for (int q = 0; q < 4; ++q) { const unsigned h2p = pkbf(xv[2 * q], xv[2 * q + 1]); hi4[q] = h2p; lo4[q] = pkbf(xv[2 * q] - bflo(h2p), xv[2 * q + 1] - bfhi(h2p)); }
                ah[ks] = __builtin_bit_cast(bf16x8, hi4); al[ks] = __builtin_bit_cast(bf16x8, lo4); }
            const float dmin = -3.0701134573253946f, dmax = -15.350567286626973f;
#pragma unroll 1
            for (int nb = 0; nb < 2; ++nb) {
                const int c = (2 * wv + nb) * 32 + r32;
                const float* w3 = P->in[I_HW3] + (size_t)l * 64 * 2048 + combo * 512 + c;
                float wv32[32];
#pragma unroll
                for (int q = 0; q < 32; ++q) wv32[q] = w3[(size_t)(16 * (q >> 3) + 8 * hh + (q & 7)) * 2048];
                f32x16 acc = (f32x16){};
#pragma unroll
                for (int ks = 0; ks < 4; ++ks) {
                    u32x4 hi4, lo4;
#pragma unroll
                    for (int q = 0; q < 4; ++q) { const float a_ = wv32[8 * ks + 2 * q], b_ = wv32[8 * ks + 2 * q + 1]; const unsigned hp2 = pkbf(a_, b_); hi4[q] = hp2; lo4[q] = pkbf(a_ - bflo(hp2), b_ - bfhi(hp2)); }
                    const bf16x8 bh = __builtin_bit_cast(bf16x8, hi4), bl = __builtin_bit_cast(bf16x8, lo4);
                    acc = __builtin_amdgcn_mfma_f32_32x32x16_bf16(ah[ks], bh, acc, 0, 0, 0);
                    acc = __builtin_amdgcn_mfma_f32_32x32x16_bf16(ah[ks], bl, acc, 0, 0, 0);
                    acc = __builtin_amdgcn_mfma_f32_32x32x16_bf16(al[ks], bh, acc, 0, 0, 0); }
                const float delta = fabsf(dmin + (dmax - dmin) * ((float)c / 511.f));
                float* kf = (L == SEQ) ? (float*)(ws + WS_KF) + ((size_t)(l * 2 + o) * 512 + c) * 4096 : (float*)(ws + WS_KFC) + ((size_t)(l * 2 + o) * 512 + c) * 512;
                const float dl2 = -delta * 1.4426950408889634f / (float)(L - 1);
#pragma unroll
                for (int rr = 0; rr < 4; ++rr) { const int lagb = lag0 + 8 * rr + 4 * hh;
                    f32x4 v;
#pragma unroll
                    for (int i = 0; i < 4; ++i) v[i] = acc[4 * rr + i] * exp2f(dl2 * (float)(lagb + i));
                    if (dir == 0) *(f32x4*)(kf + L + lagb) = v;
                    else { if (lagb > 0) kf[L - lagb] = v[0]; kf[L - lagb - 1] = v[1]; kf[L - lagb - 2] = v[2]; kf[L - lagb - 3] = v[3]; } }
            }
        }
        __syncthreads();
    }
}
constexpr int CI_IN = 8 * 88, CI_AO = 4 * 16, CI_HO = 2 * 16, CI_PO = 2 * 16, CI_OUT = 8 * 16, CI_UP = 8 * 88, CI_DN = 22 * 16;
constexpr int CONV_ALL = CI_IN + CI_AO + CI_HO + CI_PO + CI_OUT + CI_UP + CI_DN + 1;
#ifndef CONV_CB
#define CONV_CB 4
#endif
struct ConvIt { const float* src; bf16* WT; int N, n0, k0, mode, ldk, koff; };
__device__ __forceinline__ ConvIt conv_decode(PK P, unsigned char* lw, int l, int it, int tid) {
    int r = it;
    const float* W; int K, N; bf16* WT; int mode = 0, ldk = 0, koff = 0;
    if (r < CI_IN) { W = P->in[I_WIN] + (size_t)l * DM * INW; K = DM; N = INW; WT = (bf16*)(lw + LW_WIN); mode = 1; }
    else if ((r -= CI_IN) < CI_AO) { W = P->in[I_WAO] + (size_t)l * AW * DM; K = AW; N = DM; WT = (bf16*)(lw + LW_WAO); ldk = DM; }
    else if ((r -= CI_AO) < CI_HO) { W = P->in[I_WHO] + (size_t)l * HWD * DM; K = HWD; N = DM; WT = (bf16*)(lw + LW_WAO); ldk = DM; koff = 1024; }
    else if ((r -= CI_HO) < CI_PO) { W = P->in[I_WPO] + (size_t)l * PWD * DM; K = PWD; N = DM; WT = (bf16*)(lw + LW_WAO); ldk = DM; koff = 1536; }
    else if ((r -= CI_PO) < CI_OUT) { W = P->in[I_WOUT] + (size_t)l * DM * DM; K = DM; N = DM; WT = (bf16*)(lw + LW_WOUT); }
    else if ((r -= CI_OUT) < CI_UP) { W = P->in[I_WUP] + (size_t)l * DM * INW; K = DM; N = INW; WT = (bf16*)(lw + LW_WUP); mode = 2; }
    else { r -= CI_UP; W = P->in[I_WDN] + (size_t)l * FF * DM; K = FF; N = DM; WT = (bf16*)(lw + LW_WDN); }
    const int nblk = N >> 7, kb = r / nblk, nb = r - kb * nblk;
    ConvIt c; c.N = N; c.n0 = nb * 128; c.k0 = kb * 256; c.mode = mode; c.ldk = ldk ? ldk : K; c.koff = koff; c.WT = WT;
    c.src = W + (size_t)(c.k0 + (tid >> 5)) * N + c.n0 + (tid & 31) * 4;
    return c;
}
__device__ __forceinline__ void conv_items(PK P, LAS unsigned char* lds, int l, int lo, int hi, int widx, int nw) {
    int tid_ = threadIdx.x; asm volatile("" : "+v"(tid_)); const int tid = tid_, lane = tid & 63, wid = rfl(tid >> 6);
    LAS float* scr = (LAS float*)lds;
    unsigned char* lw = P->ws + WS_W + (size_t)l * LW_SIZE;
    __syncthreads();
    const int hi2 = hi < CONV_ALL - 1 ? hi : CONV_ALL - 1;
    int it = lo + widx;
    const int kr = tid >> 5, n4 = (tid & 31) * 4, c = tid & 31;
    while (it < hi2) {
        const ConvIt cur = conv_decode(P, lw, l, it, tid);
#pragma unroll
        for (int b0 = 0; b0 < 16; b0 += CONV_CB) {
            f32x4 v[CONV_CB];
#pragma unroll
            for (int i = 0; i < CONV_CB; ++i) v[i] = __builtin_nontemporal_load((const f32x4*)(cur.src + (size_t)(16 * (b0 + i)) * cur.N));
            __builtin_amdgcn_sched_barrier(0);
#pragma unroll
            for (int i = 0; i < CONV_CB; ++i) { const int k = 16 * (b0 + i) + kr; *(LAS f32x4*)(scr + k * 132 + (n4 ^ (((k >> 3) & 7) << 2))) = v[i]; }
            __builtin_amdgcn_sched_barrier(0);
        }
        __syncthreads();
#pragma unroll
        for (int j = 0; j < 8; ++j) { const int n = (tid >> 5) + 16 * j; const LAS float* s = scr + (8 * c) * 132 + (n ^ ((c & 7) << 2));
            u32x4 o; o.x = pkbf(s[0], s[132]); o.y = pkbf(s[2 * 132], s[3 * 132]); o.z = pkbf(s[4 * 132], s[5 * 132]); o.w = pkbf(s[6 * 132], s[7 * 132]);
            int nd = cur.n0 + n;
            if (cur.mode == 1 && cur.n0 < 2048) { const int d = n & 63; nd = cur.n0 + (n & 64) + 2 * (16 * (d >> 5) + (d & 15)) + ((d >> 4) & 1); }
            if (cur.mode == 2) nd = ((cur.n0 % FF) >> 7) * 256 + (cur.n0 >= FF ? 128 : 0) + n;
            __builtin_nontemporal_store(o, (u32x4*)(cur.WT + (size_t)nd * cur.ldk + cur.koff + cur.k0 + 8 * c)); }
        __syncthreads();
        it += nw;
    }
    if (lo <= CONV_ALL - 1 && CONV_ALL - 1 < hi && (CONV_ALL - 1 - lo) % nw == widx) {
        LAS float* ws_ = (LAS float*)(lds + wid * 17408);
        for (int q = wid; q < 16; q += NWAVES) { const int g = q >> 2; transpose_item(P->in[I_POOLW] + ((size_t)l * 4 + g) * 128 * 128, 128, 128, (bf16*)(lw + LW_PWT) + (size_t)g * 128 * 128, q & 3, 0, ws_, lane); }
    }
    __syncthreads();
}
__device__ __forceinline__ void misc_tables(PK P) {
    int tid_ = threadIdx.x; asm volatile("" : "+v"(tid_)); const int tid = tid_, lane = tid & 63, wid = rfl(tid >> 6);
    unsigned char* ws = P->ws;
    float* rc = (float*)(ws + WS_ROPE); float* rs = rc + 1024;
    for (int i = tid; i < 1024; i += NTHR) { const int pos = i >> 4, f = i & 15; const float inv = powf(10000.f, -(float)f / 16.f); const float ang = (float)pos * inv; rc[i] = cosf(ang); rs[i] = sinf(ang); }
    if (wid < DEPTH) { const float* lp = P->in[I_DLAM] + wid * 256; const float s1 = wave_sum(lp[lane] * lp[64 + lane]), s2 = wave_sum(lp[128 + lane] * lp[192 + lane]);
        const float li = 0.8f - 0.6f * expf(-0.3f * (float)wid);
        if (lane == 0) { float* sc = (float*)(ws + WS_SC); sc[wid * 2] = expf(s1) - expf(s2) + li; sc[wid * 2 + 1] = 1.f - li; } }
}
__device__ __forceinline__ void prologue_phase(PK P, LAS unsigned char* lds, int vcu, int G) {
    ada_items(P, lds, 0, vcu, G);
    if (vcu == 0) misc_tables(P);
    filter_items(P, lds, 0, vcu, G);
    conv_items(P, lds, 0, 0, CONV_ALL, vcu, G);
}
template <int MODE>
__device__ __forceinline__ void norm_phase(PK P, int vcu, int G, int nrows, const float* __restrict__ ada_l  , int jA,
                                           const float* __restrict__ gA, const bf16* __restrict__ Y, float* out_f32  , bool want_h,
                                           const float* __restrict__ ada_h  , int jShift, int jScale, const float* __restrict__ gB,
                                           const float* __restrict__ slab = nullptr, int nslab = 0  ) {
    int tid_ = threadIdx.x; asm volatile("" : "+v"(tid_)); const int tid = tid_, lane = tid & 63, wid = rfl(tid >> 6);
    bf16* XRES = (bf16*)(P->ws + WS_XRES); bf16* H = (bf16*)(P->ws + WS_H);
    const int stride = G * NWAVES, gw = vcu * NWAVES + wid;
    const bool deal = (nrows == RT) && (stride == 2048);
    const int per = (!deal && nrows % stride == 0) ? nrows / stride : 0;
    const int nmine = deal ? (gw < 1024 ? 4 : 5) : (per ? per : (nrows - gw + stride - 1) / stride);
#define NP_ROW(i) (deal ? (gw < 1024 ? ((i) == 0 ? RX + gw : 3 * gw + ((i) - 1)) : 3072 + 5 * (gw - 1024) + (i)) : (per ? per * gw + (i) : gw + stride * (i)))
    f32x4 xn[8]; u32x2 yn[8], xr2[8];
#define NP_LOAD(r) do { const int r_ = (r); \
        if (MODE == 0) { const float* xr_ = (r_ < RX) ? P->in[I_X] + (size_t)r_ * DM : P->in[I_CTX] + (size_t)(r_ - RX) * DM; \
            _Pragma("unroll") for (int j = 0; j < 8; ++j) xn[j] = *(const f32x4*)(xr_ + 4 * (lane + 64 * j)); } \
        else { const bf16* xr_ = XRES + (size_t)r_ * DM; const bf16* yr_ = Y + (size_t)r_ * DM; \
            _Pragma("unroll") for (int j = 0; j < 8; ++j) { xr2[j] = *(const u32x2*)(xr_ + 4 * (lane + 64 * j)); \
                if (r_ < RX || nslab == 0) yn[j] = *(const u32x2*)(yr_ + 4 * (lane + 64 * j)); } } __builtin_amdgcn_sched_barrier(0); } while (0)
    if (nmine > 0) NP_LOAD(NP_ROW(0));
    f32x4 mg[8], sg[8], sh8[8];
    int acur = -1;
    for (int it = 0; it < nmine; ++it) {
        const int row = NP_ROW(it);
        const int arow = (row < RX) ? (row >> 11) : 4;
        if (arow != acur) {
            acur = arow;
            int lq = lane; asm volatile("" : "+v"(lq));
            if (MODE != 0) { const float* mA = ada_l + (size_t)arow * 12288 + jA * DM;
#pragma unroll
                for (int j0 = 0; j0 < 8; j0 += 4) { f32x4 m[4], g[4];
#pragma unroll
                    for (int j = 0; j < 4; ++j) { const int e = 4 * (lq + 64 * (j0 + j)); m[j] = *(const f32x4*)(mA + e); g[j] = *(const f32x4*)(gA + e); }
                    __builtin_amdgcn_sched_barrier(0);
#pragma unroll
                    for (int j = 0; j < 4; ++j) mg[j0 + j] = m[j] * g[j];
                    __builtin_amdgcn_sched_barrier(0); } }
            if (want_h) { const float* mSh = ada_h + (size_t)arow * 12288 + jShift * DM; const float* mSc = ada_h + (size_t)arow * 12288 + jScale * DM;
#pragma unroll
                for (int j0 = 0; j0 < 8; j0 += 4) { f32x4 sc[4], g[4];
#pragma unroll
                    for (int j = 0; j < 4; ++j) { const int e = 4 * (lq + 64 * (j0 + j)); sh8[j0 + j] = *(const f32x4*)(mSh + e); sc[j] = *(const f32x4*)(mSc + e); g[j] = *(const f32x4*)(gB + e); }
                    __builtin_amdgcn_sched_barrier(0);
#pragma unroll
                    for (int j = 0; j < 4; ++j) sg[j0 + j] = g[j] * (sc[j] + 1.f);
                    __builtin_amdgcn_sched_barrier(0); } }
        }
        f32x4 x[8];
#pragma unroll
        for (int j = 0; j < 8; ++j) x[j] = (MODE == 0) ? xn[j] : (f32x4){bflo(xr2[j].x), bfhi(xr2[j].x), bflo(xr2[j].y), bfhi(xr2[j].y)};
        if (MODE != 0) {
            f32x4 y[8]; float ss = 0.f;
#pragma unroll
            for (int j = 0; j < 8; ++j) {
                if (row < RX || nslab == 0) y[j] = (f32x4){bflo(yn[j].x), bfhi(yn[j].x), bflo(yn[j].y), bfhi(yn[j].y)};
                else { const bf16* sp = (const bf16*)slab + (size_t)(row - RX) * DM + 4 * (lane + 64 * j); y[j] = (f32x4){0.f, 0.f, 0.f, 0.f};
                    for (int s = 0; s < nslab; ++s) { const u32x2 u = *(const u32x2*)(sp + (size_t)s * RC * DM); y[j] += (f32x4){bflo(u.x), bfhi(u.x), bflo(u.y), bfhi(u.y)}; } }
                ss += (y[j].x * y[j].x + y[j].y * y[j].y) + (y[j].z * y[j].z + y[j].w * y[j].w); }
            const float rstd = rsqrtf(wave_sum(ss) * (1.f / DM) + EPS);
#pragma unroll
            for (int j = 0; j < 8; ++j) x[j] += mg[j] * (y[j] * rstd);
            __builtin_amdgcn_sched_barrier(0);
            if (it + 1 < nmine) NP_LOAD(NP_ROW(it + 1));
        } else { if (it + 1 < nmine) NP_LOAD(NP_ROW(it + 1)); }
        if (out_f32) { float* xo = out_f32 + (size_t)row * DM;
#pragma unroll
          for (int j = 0; j < 8; ++j) *(f32x4*)(xo + 4 * (lane + 64 * j)) = x[j]; }
        else { bf16* xo = XRES + (size_t)row * DM;
#pragma unroll
          for (int j = 0; j < 8; ++j) { u32x2 o; o.x = pkbf(x[j].x, x[j].y); o.y = pkbf(x[j].z, x[j].w); *(u32x2*)(xo + 4 * (lane + 64 * j)) = o;
              x[j] = (f32x4){bflo(o.x), bfhi(o.x), bflo(o.y), bfhi(o.y)}; } }
        if (want_h) {
            float ss = 0.f;
#pragma unroll
            for (int j = 0; j < 8; ++j) ss += (x[j].x * x[j].x + x[j].y * x[j].y) + (x[j].z * x[j].z + x[j].w * x[j].w);
            const float rstd = rsqrtf(wave_sum(ss) * (1.f / DM) + EPS);
            bf16* hr = H + (size_t)row * DM;
#pragma unroll
            for (int j = 0; j < 8; ++j) { const int e = 4 * (lane + 64 * j); const f32x4 h = (x[j] * rstd) * sg[j] + sh8[j]; u32x2 o; o.x = pkbf(h.x, h.y); o.y = pkbf(h.z, h.w); *(u32x2*)(hr + e) = o; }
        }
    }
#undef NP_LOAD
#undef NP_ROW
}

__device__ __forceinline__ void act_edge_phase(PK P, int vcu, int G, int nrows, const float* __restrict__ cw  ) {
    int tid_ = threadIdx.x; asm volatile("" : "+v"(tid_)); const int tid = tid_;
    const bf16* EG = (const bf16*)(P->ws + WS_EG); const bf16* EV = (const bf16*)(P->ws + WS_EV); bf16* ACT = (bf16*)(P->ws + WS_ACT);
    const int nblk = nrows >> 6, nitems = nblk * 2 * (FF / 8);
    for (int it = vcu * NTHR + tid; it < nitems; it += G * NTHR) {
        const int cch = it % (FF / 8), rb = it / (FF / 8), b = rb >> 1, lastr = rb & 1, ch = cch * 8;
        const int row = b * 64 + (lastr ? 63 : 0);
        const int tq = (row < RX) ? (row & (SEQ - 1)) : ((row - RX) & (CTX - 1)); const int Ls = (row < RX) ? SEQ : CTX;
        u32x4 up = {0u, 0u, 0u, 0u}, dn = {0u, 0u, 0u, 0u}, cur, vv;
        if (!lastr) { cur = *(const u32x4*)(EG + ((size_t)b * 4 + 0) * FF + ch); dn = *(const u32x4*)(EG + ((size_t)b * 4 + 1) * FF + ch); vv = *(const u32x4*)(EV + ((size_t)b * 2 + 0) * FF + ch);
            if (tq > 0) up = *(const u32x4*)(EG + ((size_t)(b - 1) * 4 + 3) * FF + ch); }
        else { cur = *(const u32x4*)(EG + ((size_t)b * 4 + 3) * FF + ch); up = *(const u32x4*)(EG + ((size_t)b * 4 + 2) * FF + ch); vv = *(const u32x4*)(EV + ((size_t)b * 2 + 1) * FF + ch);
            if (tq + 1 < Ls) dn = *(const u32x4*)(EG + ((size_t)(b + 1) * 4 + 0) * FF + ch); }
        float w0[8], w1[8], w2[8];
#pragma unroll
        for (int i = 0; i < 8; i += 4) { *(f32x4*)(w0 + i) = *(const f32x4*)(cw + ch + i); *(f32x4*)(w1 + i) = *(const f32x4*)(cw + FF + ch + i); *(f32x4*)(w2 + i) = *(const f32x4*)(cw + 2 * FF + ch + i); }
        float o[8];
#pragma unroll
        for (int q = 0; q < 4; ++q) {
            o[2 * q] = gelu_tanh_f(w0[2 * q] * bflo(up[q]) + w1[2 * q] * bflo(cur[q]) + w2[2 * q] * bflo(dn[q])) * bflo(vv[q]);
            o[2 * q + 1] = gelu_tanh_f(w0[2 * q + 1] * bfhi(up[q]) + w1[2 * q + 1] * bfhi(cur[q]) + w2[2 * q + 1] * bfhi(dn[q])) * bfhi(vv[q]);
        }
        u32x4 w; w.x = pkbf(o[0], o[1]); w.y = pkbf(o[2], o[3]); w.z = pkbf(o[4], o[5]); w.w = pkbf(o[6], o[7]);
        *(u32x4*)(ACT + (size_t)row * FF + ch) = w;
    }
}

constexpr int AT_STAGE = 32768;
__device__ __forceinline__ s16x4 vtr(const LAS unsigned char* p) { typedef short v4i16_t __attribute__((ext_vector_type(4))); return __builtin_bit_cast(s16x4, __builtin_amdgcn_ds_read_tr16_b64_v4i16((LAS v4i16_t*)p)); }

#define DS_RD128(dst, addr, OFF) asm volatile("ds_read_b128 %0, %1 offset:%2" : "=&v"(dst) : "v"(addr), "n"(OFF))
#define DS_RDTR(dst, addr, OFF) asm volatile("ds_read_b64_tr_b16 %0, %1 offset:%2" : "=&v"(dst) : "v"(addr), "n"(OFF))
#define V_READ(S, blk) do { DS_RDTR(S[0], vaddr, ((blk) * 4 + 0) * 1024); DS_RDTR(S[1], vaddr, ((blk) * 4 + 0) * 1024 + 512); DS_RDTR(S[2], vaddr, ((blk) * 4 + 1) * 1024); DS_RDTR(S[3], vaddr, ((blk) * 4 + 1) * 1024 + 512); \
        DS_RDTR(S[4], vaddr, ((blk) * 4 + 2) * 1024); DS_RDTR(S[5], vaddr, ((blk) * 4 + 2) * 1024 + 512); DS_RDTR(S[6], vaddr, ((blk) * 4 + 3) * 1024); DS_RDTR(S[7], vaddr, ((blk) * 4 + 3) * 1024 + 512); } while (0)
#define V_WAIT(N, S) asm volatile("s_waitcnt lgkmcnt(" #N ")" : "+v"(S[0]), "+v"(S[1]), "+v"(S[2]), "+v"(S[3]), "+v"(S[4]), "+v"(S[5]), "+v"(S[6]), "+v"(S[7]))
#define PV4(blk, S) do { _Pragma("unroll") for (int ks_ = 0; ks_ < 4; ++ks_) { const bf16x8 vf_ = {S[2 * ks_][0], S[2 * ks_][1], S[2 * ks_][2], S[2 * ks_][3], S[2 * ks_ + 1][0], S[2 * ks_ + 1][1], S[2 * ks_ + 1][2], S[2 * ks_ + 1][3]}; \
        o[blk] = __builtin_amdgcn_mfma_f32_32x32x16_bf16(vf_, __builtin_bit_cast(bf16x8, pw[ks_]), o[blk], 0, 0, 0); } } while (0)
__device__ __forceinline__ void attn_unit(LAS unsigned char* lds, const bf16* __restrict__ QKV, bf16* __restrict__ MIXA, float lam, float oscale, const float* __restrict__ subg,
                                          int b, int h, int qb, bool isctx) {
    int tid_ = threadIdx.x; asm volatile("" : "+v"(tid_)); const int tid = tid_, lane = tid & 63, wid = rfl(tid >> 6), r32 = lane & 31, hi = lane >> 5;
    const int mp = wid & 1, g = wid >> 1;
    const int seq0 = isctx ? RX + b * CTX : b * SEQ, ctx0 = RX + b * CTX;
    const int qrow = seq0 + qb * 128 + g * 32 + r32;
    const int NT = isctx ? 4 : 36;
    bf16x8 qf[4];
    { const bf16* qp = QKV + (size_t)qrow * NQKV + h * 128 + mp * 64 + hi * 8;
#pragma unroll
      for (int d0 = 0; d0 < 4; ++d0) qf[d0] = *(const bf16x8*)(qp + d0 * 16); }
    const int kkey = 8 * wid + (lane >> 3);
    const bf16* kbase = QKV + 1024 + h * 128 + (size_t)kkey * NQKV + (((lane & 7) ^ ((kkey >> 1) & 7)) << 3);
    const bf16* vbase = QKV + 2048 + h * 128 + (wid >> 1) * 32 + (lane & 3) * 8;
    const int vrow = 16 * ((2 * wid) & 3) + (lane >> 2);
    const int kdst = wid * 1024 + lane * 16, vdst = 16384 + (2 * wid) * 1024 + lane * 16;
#define AT_KROW(t) (isctx ? seq0 + 64 * (t) : ((t) < 32 ? seq0 + 64 * (t) : ctx0 + 64 * ((t) - 32)))
#define AT_DMA(t, st) do { const int kr_ = AT_KROW(t); LAS unsigned char* b_ = lds + (st) * AT_STAGE; const bf16* kp_ = kbase + (size_t)kr_ * NQKV; const bf16* vp_ = vbase + (size_t)(kr_ + vrow) * NQKV; \
        __builtin_amdgcn_global_load_lds((const unsigned*)kp_, (LAS unsigned*)(b_ + wid * 1024), 16, 0, 0); \
        __builtin_amdgcn_global_load_lds((const unsigned*)(kp_ + 64), (LAS unsigned*)(b_ + 8192 + wid * 1024), 16, 0, 0); \
        __builtin_amdgcn_global_load_lds((const unsigned*)vp_, (LAS unsigned*)(b_ + 16384 + (2 * wid) * 1024), 16, 0, 0); \
        __builtin_amdgcn_global_load_lds((const unsigned*)(vp_ + (size_t)16 * NQKV), (LAS unsigned*)(b_ + 16384 + (2 * wid + 1) * 1024), 16, 0, 0); } while (0)
#define AT_BAR(N) do { asm volatile("s_waitcnt vmcnt(" #N ")" ::: "memory"); __builtin_amdgcn_s_barrier(); asm volatile("" ::: "memory"); } while (0)
    AT_DMA(0, 0); if (NT > 1) AT_DMA(1, 1);
    if (NT > 1) AT_BAR(4); else AT_BAR(0);
    f32x16 o[4];
#pragma unroll
    for (int i = 0; i < 4; ++i) o[i] = (f32x16){};
    float mref = 0.f, lrun = 0.f;
    f32x16 negm = (f32x16){};
    int kofs[4];
#pragma unroll
    for (int d0 = 0; d0 < 4; ++d0) kofs[d0] = mp * 8192 + r32 * 128 + (((2 * d0 + hi) ^ ((r32 >> 1) & 7)) << 4);
    const int voff = 16384 + (4 * hi + ((lane & 15) >> 2)) * 64 + ((lane >> 4) & 1) * 32 + (lane & 3) * 8;
    u32x4 pw[4];
    int sc = 0, sp = 2;
#define QK_TILE() \
        f32x16 p0 = negm, p1 = negm; \
        { const unsigned kst = (unsigned)(uintptr_t)(lds + sc * AT_STAGE); bf16x8 kf[8]; \
          DS_RD128(kf[0], kst + kofs[0], 0); DS_RD128(kf[1], kst + kofs[0], 4096); DS_RD128(kf[2], kst + kofs[1], 0); DS_RD128(kf[3], kst + kofs[1], 4096); \
          DS_RD128(kf[4], kst + kofs[2], 0); DS_RD128(kf[5], kst + kofs[2], 4096); DS_RD128(kf[6], kst + kofs[3], 0); DS_RD128(kf[7], kst + kofs[3], 4096); \
          asm volatile("s_waitcnt lgkmcnt(6)" : "+v"(kf[0]), "+v"(kf[1])); \
          p0 = __builtin_amdgcn_mfma_f32_32x32x16_bf16(kf[0], qf[0], p0, 0, 0, 0); p1 = __builtin_amdgcn_mfma_f32_32x32x16_bf16(kf[1], qf[0], p1, 0, 0, 0); \
          asm volatile("s_waitcnt lgkmcnt(4)" : "+v"(kf[2]), "+v"(kf[3])); \
          p0 = __builtin_amdgcn_mfma_f32_32x32x16_bf16(kf[2], qf[1], p0, 0, 0, 0); p1 = __builtin_amdgcn_mfma_f32_32x32x16_bf16(kf[3], qf[1], p1, 0, 0, 0); \
          asm volatile("s_waitcnt lgkmcnt(2)" : "+v"(kf[4]), "+v"(kf[5])); \
          p0 = __builtin_amdgcn_mfma_f32_32x32x16_bf16(kf[4], qf[2], p0, 0, 0, 0); p1 = __builtin_amdgcn_mfma_f32_32x32x16_bf16(kf[5], qf[2], p1, 0, 0, 0); \
          asm volatile("s_waitcnt lgkmcnt(0)" : "+v"(kf[6]), "+v"(kf[7])); \
          p0 = __builtin_amdgcn_mfma_f32_32x32x16_bf16(kf[6], qf[3], p0, 0, 0, 0); p1 = __builtin_amdgcn_mfma_f32_32x32x16_bf16(kf[7], qf[3], p1, 0, 0, 0); }
#define ROWMAX(rm) do { asm volatile("s_nop 15\n\ts_nop 7" : "+v"(p0), "+v"(p1)); \
        float a_ = max3f(p0[0], p0[1], p1[0]), b_ = max3f(p0[2], p0[3], p1[1]); a_ = max3f(a_, p1[2], p1[3]); \
        _Pragma("unroll") for (int r = 4; r < 16; r += 4) { a_ = max3f(a_, p0[r], p0[r + 1]); b_ = max3f(b_, p0[r + 2], p0[r + 3]); a_ = max3f(a_, p1[r], p1[r + 1]); b_ = max3f(b_, p1[r + 2], p1[r + 3]); } \
        rm = xhalf_max(max3f(a_, b_, b_)); } while (0)
#define EXP8(P, B, ls) do { _Pragma("unroll") for (int r = (B); r < (B) + 8; ++r) { P[r] = __builtin_amdgcn_exp2f(P[r]); ls += P[r]; } } while (0)
#define PACK_P() do { _Pragma("unroll") for (int s_ = 0; s_ < 2; ++s_) { \
            pw[s_] = (u32x4){pkbf(p0[8 * s_], p0[8 * s_ + 1]), pkbf(p0[8 * s_ + 2], p0[8 * s_ + 3]), pkbf(p0[8 * s_ + 4], p0[8 * s_ + 5]), pkbf(p0[8 * s_ + 6], p0[8 * s_ + 7])}; \
            pw[2 + s_] = (u32x4){pkbf(p1[8 * s_], p1[8 * s_ + 1]), pkbf(p1[8 * s_ + 2], p1[8 * s_ + 3]), pkbf(p1[8 * s_ + 4], p1[8 * s_ + 5]), pkbf(p1[8 * s_ + 6], p1[8 * s_ + 7])}; } } while (0)
    {
        if (NT > 2) AT_DMA(2, 2);
        __builtin_amdgcn_sched_barrier(0);
        QK_TILE();
        float rm; ROWMAX(rm);
        mref = rm;
#pragma unroll
        for (int r = 0; r < 16; ++r) { p0[r] -= rm; p1[r] -= rm; negm[r] = -mref; }
        float ls = 0.f; EXP8(p0, 0, ls); EXP8(p0, 8, ls); EXP8(p1, 0, ls); EXP8(p1, 8, ls);
        lrun = ls;
        PACK_P();
        __builtin_amdgcn_sched_barrier(0);
        if (NT > 2) AT_BAR(4); else AT_BAR(0);
    }
    sp = 0; sc = 1;
    for (int t = 1; t < NT; ++t) {
        if (t + 2 < NT) AT_DMA(t + 2, (sc + 2) & 3);
        __builtin_amdgcn_sched_barrier(0);
        const unsigned vaddr = (unsigned)(uintptr_t)(lds + sp * AT_STAGE + voff);
        s16x4 va[8], vb[8];
        V_READ(va, 0);
        QK_TILE();
        float rm; ROWMAX(rm);
        const bool resc = __any(rm > 8.f);
        float alpha = 1.f;
        if (__builtin_expect(resc, 0)) { asm volatile("; rescale (rare): keep this a real branch" ::: "memory");
            const float dl = fmaxf(rm, 0.f); alpha = __builtin_amdgcn_exp2f(-dl); mref += dl;
#pragma unroll
            for (int r = 0; r < 16; ++r) { p0[r] -= dl; p1[r] -= dl; negm[r] = -mref; } }
        float ls = 0.f;
#define PV_STEP(blk, S, ks, P, r0) do { const bf16x8 vf_ = {S[2 * (ks)][0], S[2 * (ks)][1], S[2 * (ks)][2], S[2 * (ks)][3], S[2 * (ks) + 1][0], S[2 * (ks) + 1][1], S[2 * (ks) + 1][2], S[2 * (ks) + 1][3]}; \
            o[blk] = __builtin_amdgcn_mfma_f32_32x32x16_bf16(vf_, __builtin_bit_cast(bf16x8, pw[ks]), o[blk], 0, 0, 0); \
            P[r0] = __builtin_amdgcn_exp2f(P[r0]); P[(r0) + 1] = __builtin_amdgcn_exp2f(P[(r0) + 1]); ls += P[r0] + P[(r0) + 1]; asm volatile("" : "+v"(P), "+v"(ls)); __builtin_amdgcn_sched_barrier(0); } while (0)
        V_READ(vb, 1); V_WAIT(8, va); PV_STEP(0, va, 0, p0, 0); PV_STEP(0, va, 1, p0, 2); PV_STEP(0, va, 2, p0, 4); PV_STEP(0, va, 3, p0, 6);
        V_READ(va, 2); V_WAIT(8, vb); PV_STEP(1, vb, 0, p0, 8); PV_STEP(1, vb, 1, p0, 10); PV_STEP(1, vb, 2, p0, 12); PV_STEP(1, vb, 3, p0, 14);
        V_READ(vb, 3); V_WAIT(8, va); PV_STEP(2, va, 0, p1, 0); PV_STEP(2, va, 1, p1, 2); PV_STEP(2, va, 2, p1, 4); PV_STEP(2, va, 3, p1, 6);
        V_WAIT(0, vb); PV_STEP(3, vb, 0, p1, 8); PV_STEP(3, vb, 1, p1, 10); PV_STEP(3, vb, 2, p1, 12); PV_STEP(3, vb, 3, p1, 14);
#undef PV_STEP
        if (__builtin_expect(resc, 0)) { asm volatile("; rescale (rare)" ::: "memory"); lrun *= alpha;
#pragma unroll
            for (int i = 0; i < 4; ++i) o[i] *= alpha; }
        lrun += ls;
        PACK_P();
        __builtin_amdgcn_sched_barrier(0);
        if (t + 2 < NT) AT_BAR(4); else AT_BAR(0);
        sp = sc; sc = (sc + 1) & 3;
    }
    {
        const unsigned vaddr = (unsigned)(uintptr_t)(lds + sp * AT_STAGE + voff);
        s16x4 va[8], vb[8];
        V_READ(va, 0);
        V_READ(vb, 1); V_WAIT(8, va); PV4(0, va);
        V_READ(va, 2); V_WAIT(8, vb); PV4(1, vb);
        V_READ(vb, 3); V_WAIT(8, va); PV4(2, va);
        V_WAIT(0, vb); PV4(3, vb);
    }
    __syncthreads();
#undef QK_TILE
#undef ROWMAX
#undef EXP8
#undef PACK_P
#undef AT_KROW
#undef AT_DMA
#undef AT_BAR
#undef DS_RD128
#undef DS_RDTR
#undef V_READ
#undef V_WAIT
#undef PV4
    const float inv = 1.f / xhalf_sum(lrun);
    LAS float* ex = (LAS float*)(lds + g * 16384) + lane;
    if (mp == 1) {
#pragma unroll
        for (int blk = 0; blk < 4; ++blk)
#pragma unroll
            for (int r = 0; r < 16; ++r) ex[(blk * 16 + r) * 64] = o[blk][r] * inv;
    }
    __syncthreads();
    if (mp == 0) {
        float ss = 0.f;
#pragma unroll
        for (int blk = 0; blk < 4; ++blk)
#pragma unroll
            for (int r = 0; r < 16; ++r) { const float d = o[blk][r] * inv - lam * ex[(blk * 16 + r) * 64]; o[blk][r] = d; ss += d * d; }
        ss = xhalf_sum(ss);
        const float rs = rsqrtf(ss * (1.f / 128.f) + EPS) * oscale;
        bf16* op = MIXA + (size_t)qrow * DM + h * 128 + 4 * hi;
#pragma unroll
        for (int blk = 0; blk < 4; ++blk)
#pragma unroll
            for (int rr = 0; rr < 4; ++rr) { const int vd = 32 * blk + 8 * rr; const f32x4 gg = *(const f32x4*)(subg + vd + 4 * hi);
                u32x2 w; w.x = pkbf(o[blk][4 * rr] * rs * gg.x, o[blk][4 * rr + 1] * rs * gg.y); w.y = pkbf(o[blk][4 * rr + 2] * rs * gg.z, o[blk][4 * rr + 3] * rs * gg.w);
                *(u32x2*)(op + vd) = w; }
    }
    __syncthreads();
}
constexpr int HY_FC = 0, HY_FCS = 8224, HY_U = 8 * HY_FCS, HY_US = 5008  , HY_XS = 4112  , HY_X1 = HY_U + 4 * HY_US, HY_X2 = HY_X1 + 4 * HY_XS,
              HY_KFS = HY_X2 + 4 * HY_XS  , HY_RED = HY_KFS + 16384 + 128, HY_END = HY_RED + 64;
static_assert(HY_END <= MISC_OFF, "hyena LDS");

struct HyRegs { u32x4 ch[3][2]; unsigned hp[3][2], hn[3][2]; float k0[8], k1[8]; };
__device__ __forceinline__ void hy_load(HyRegs& R, PK P, int l, int c, bool isctx, int tid) {
    const int L = isctx ? CTX : SEQ, row0 = isctx ? RX : 0, l8 = L >> 3, nch = 4 * l8;
    const bf16* HYT = (const bf16*)(P->ws + WS_HYT);
#pragma unroll
    for (int a = 0; a < 3; ++a)
#pragma unroll
        for (int j = 0; j < 2; ++j) {
            const int e = min(tid + NTHR * j, nch - 1);
            const int n = e / l8, t0 = (e - n * l8) * 8;
            const bf16* sp = HYT + (size_t)(a * 512 + c) * RT + row0 + (size_t)n * L + t0;
            R.ch[a][j] = *(const u32x4*)sp;
            R.hp[a][j] = *(const unsigned*)(sp + ((t0 > 0) ? -2 : 0));
            R.hn[a][j] = *(const unsigned*)(sp + ((t0 + 8 < L) ? 8 : 6));
        }
    const float* kf0 = isctx ? (const float*)(P->ws + WS_KFC) + ((size_t)(l * 2) * 512 + c) * 512 : (const float*)(P->ws + WS_KF) + ((size_t)(l * 2) * 512 + c) * 4096;
    const float* kf1 = kf0 + (isctx ? (size_t)512 * 512 : (size_t)512 * 4096);
#pragma unroll
    for (int j = 0; j < 8; ++j) { const int i = min(max(tid + NTHR * j, 1), 2 * L - 1); R.k0[j] = kf0[i]; R.k1[j] = kf1[i]; }
    __builtin_amdgcn_sched_barrier(0);
}
__device__ __forceinline__ void hy_fill_conv3(LAS unsigned char* dst, int dstS, int pad, const u32x4 (&ch)[2], const unsigned (&hp)[2], const unsigned (&hn)[2], int L, float w0, float w1, float w2, int tid) {
    const int l8 = L >> 3, nch = 4 * l8;
#pragma unroll
    for (int j = 0; j < 2; ++j) {
        const int e = tid + NTHR * j;
        if (e < nch) {
            const int n = e / l8, t0 = (e - n * l8) * 8; const u32x4 v = ch[j];
            float x[10] = {(t0 > 0) ? bfhi(hp[j]) : 0.f, bflo(v.x), bfhi(v.x), bflo(v.y), bfhi(v.y), bflo(v.z), bfhi(v.z), bflo(v.w), bfhi(v.w), (t0 + 8 < L) ? bflo(hn[j]) : 0.f};
            u32x4 o;
            o.x = pkbf(w0 * x[0] + w1 * x[1] + w2 * x[2], w0 * x[1] + w1 * x[2] + w2 * x[3]); o.y = pkbf(w0 * x[2] + w1 * x[3] + w2 * x[4], w0 * x[3] + w1 * x[4] + w2 * x[5]);
            o.z = pkbf(w0 * x[4] + w1 * x[5] + w2 * x[6], w0 * x[5] + w1 * x[6] + w2 * x[7]); o.w = pkbf(w0 * x[6] + w1 * x[7] + w2 * x[8], w0 * x[7] + w1 * x[8] + w2 * x[9]);
            *(LAS u32x4*)(dst + n * dstS + (pad + t0) * 2) = o;
        }
    }
}
__device__ __forceinline__ float hy_fill_filter(LAS unsigned char* lds, const float (&kf)[8], int L, int tid, int lane, int wid) {
    LAS float* kfs = (LAS float*)(lds + HY_KFS) + 16; LAS float* red = (LAS float*)(lds + HY_RED);
    float s = 0.f;
#pragma unroll
    for (int j = 0; j < 8; ++j) { const int i = tid + NTHR * j; if (i < 2 * L) { const float kv = (i >= 1) ? kf[j] : 0.f; kfs[i] = kv; s += fabsf(kv); } }
    if (tid < 24) kfs[tid < 16 ? tid - 16 : 2 * L + tid - 16] = 0.f;
    s = wave_sum(s);
    if (lane == 0) red[wid] = s;
    __syncthreads();
    float tot = 0.f;
#pragma unroll
    for (int i = 0; i < 8; ++i) tot += red[i];
    const int ny8 = (2 * L + 16) >> 3;
    for (int e = tid; e < ny8; e += NTHR) {
        const int y0 = e * 8;
        float w[16];
#pragma unroll
        for (int k4 = 0; k4 < 16; k4 += 4) *(f32x4*)(w + k4) = *(const LAS f32x4*)(kfs + 2 * L - y0 - 8 + k4);
#pragma unroll
        for (int rho = 0; rho < 8; ++rho) {
            u32x4 o; o.x = pkbf(w[rho + 8], w[rho + 7]); o.y = pkbf(w[rho + 6], w[rho + 5]); o.z = pkbf(w[rho + 4], w[rho + 3]); o.w = pkbf(w[rho + 2], w[rho + 1]);
            *(LAS u32x4*)(lds + HY_FC + rho * HY_FCS + y0 * 2) = o; }
    }
    return 1.f / (tot + EPS);
}
__device__ __forceinline__ f32x16 hy_conv_tile(const LAS unsigned char* lds, int L, int a0, int lane) {
    const int i = lane & 31, h = lane >> 5, q = i >> 2, n = i & 3, nb = L >> 5;
    f32x16 acc = (f32x16){};
    const int dlo = a0 - (nb - 1), dhi = a0 + 7;
    const LAS unsigned char* ap = lds + HY_FC + (i & 7) * HY_FCS + 2 * (L + 8 * h - 8 * (i >> 3) - 32 * dlo);
    const LAS unsigned char* bp = lds + HY_U + n * HY_US + 2 * (224 + 32 * (a0 - dlo + q) + 8 * h);
    f32x16 acc2 = (f32x16){};
    bf16x8 A0 = *(const LAS bf16x8*)ap, A1 = *(const LAS bf16x8*)(ap + 32), B0 = *(const LAS bf16x8*)bp, B1 = *(const LAS bf16x8*)(bp + 32);
    for (int d = dlo; d < dhi; ++d) {
        ap -= 64; bp -= 64;
        const bf16x8 nA0 = *(const LAS bf16x8*)ap, nA1 = *(const LAS bf16x8*)(ap + 32), nB0 = *(const LAS bf16x8*)bp, nB1 = *(const LAS bf16x8*)(bp + 32);
        acc = __builtin_amdgcn_mfma_f32_32x32x16_bf16(A0, B0, acc, 0, 0, 0);
        acc2 = __builtin_amdgcn_mfma_f32_32x32x16_bf16(A1, B1, acc2, 0, 0, 0);
        A0 = nA0; A1 = nA1; B0 = nB0; B1 = nB1;
    }
    acc = __builtin_amdgcn_mfma_f32_32x32x16_bf16(A0, B0, acc, 0, 0, 0);
    acc2 = __builtin_amdgcn_mfma_f32_32x32x16_bf16(A1, B1, acc2, 0, 0, 0);
    return acc + acc2;
}

__device__ __forceinline__ void hyena_compute(LAS unsigned char* lds, PK P, const HyRegs& R, int l, int c, bool isctx) {
    int tid_ = threadIdx.x; asm volatile("" : "+v"(tid_)); const int tid = tid_, lane = tid & 63, wid = rfl(tid >> 6);
    const int L = isctx ? CTX : SEQ, row0 = isctx ? RX : 0, ntile = L >> 8;
    bf16* MIXA = (bf16*)(P->ws + WS_MIXA);
    const float* sw = P->in[I_HYSW] + (size_t)l * 3 * 1536;
    const float bias0 = P->in[I_HBIAS][(size_t)l * 1024 + c], bias1 = P->in[I_HBIAS][(size_t)l * 1024 + 512 + c];
    for (int e = tid; e < 4 * 448 / 8; e += NTHR) { const int n = e / 56, k = e - n * 56; const int off = (k < 28) ? k * 16 : (224 + L) * 2 + (k - 28) * 16;
        *(LAS u32x4*)(lds + HY_U + n * HY_US + off) = (u32x4){0u, 0u, 0u, 0u}; }
    hy_fill_conv3(lds + HY_U, HY_US, 224, R.ch[0], R.hp[0], R.hn[0], L, sw[c], sw[1536 + c], sw[3072 + c], tid);
    hy_fill_conv3(lds + HY_X1, HY_XS, 0, R.ch[1], R.hp[1], R.hn[1], L, sw[512 + c], sw[1536 + 512 + c], sw[3072 + 512 + c], tid);
    hy_fill_conv3(lds + HY_X2, HY_XS, 0, R.ch[2], R.hp[2], R.hn[2], L, sw[1024 + c], sw[1536 + 1024 + c], sw[3072 + 1024 + c], tid);
    const float inv0 = hy_fill_filter(lds, R.k0, L, tid, lane, wid);
    __syncthreads();
    const int a0 = 8 * wid, i32 = lane & 31, h = lane >> 5, q = i32 >> 2, n = i32 & 3;
    const int tb = 32 * (a0 + q) + 4 * h;
    u32x2 zpk[4];
    if (wid < ntile) {
        const f32x16 acc = hy_conv_tile(lds, L, a0, lane);
#pragma unroll
        for (int rr = 0; rr < 4; ++rr) { const int t = tb + 8 * rr;
            const u32x2 uv = *(const LAS u32x2*)(lds + HY_U + n * HY_US + (224 + t) * 2), x1 = *(const LAS u32x2*)(lds + HY_X1 + n * HY_XS + t * 2);
            const float y0 = acc[4 * rr] * inv0 + bflo(uv.x) * bias0, y1 = acc[4 * rr + 1] * inv0 + bfhi(uv.x) * bias0, y2 = acc[4 * rr + 2] * inv0 + bflo(uv.y) * bias0, y3 = acc[4 * rr + 3] * inv0 + bfhi(uv.y) * bias0;
            zpk[rr].x = pkbf(bflo(x1.x) * y0, bfhi(x1.x) * y1); zpk[rr].y = pkbf(bflo(x1.y) * y2, bfhi(x1.y) * y3); }
    }
    __syncthreads();
    if (wid < ntile) {
#pragma unroll
        for (int rr = 0; rr < 4; ++rr) *(LAS u32x2*)(lds + HY_U + n * HY_US + (224 + tb + 8 * rr) * 2) = zpk[rr];
    }
    const float inv1 = hy_fill_filter(lds, R.k1, L, tid, lane, wid);
    __syncthreads();
    if (wid < ntile) {
        const f32x16 acc = hy_conv_tile(lds, L, a0, lane);
        bf16* op = MIXA + (size_t)(row0 + n * L) * DM + 1024 + c;
#pragma unroll
        for (int rr = 0; rr < 4; ++rr) { const int t = tb + 8 * rr;
            const u32x2 x2 = *(const LAS u32x2*)(lds + HY_X2 + n * HY_XS + t * 2);
            const float z0 = bflo(zpk[rr].x), z1 = bfhi(zpk[rr].x), z2 = bflo(zpk[rr].y), z3 = bfhi(zpk[rr].y);
            const float o0 = bflo(x2.x) * (acc[4 * rr] * inv1 + z0 * bias1), o1 = bfhi(x2.x) * (acc[4 * rr + 1] * inv1 + z1 * bias1);
            const float o2 = bflo(x2.y) * (acc[4 * rr + 2] * inv1 + z2 * bias1), o3 = bfhi(x2.y) * (acc[4 * rr + 3] * inv1 + z3 * bias1);
            const unsigned a = pkbf(o0, o1), bq = pkbf(o2, o3);
            op[(size_t)t * DM] = (bf16)(a & 0xffffu); op[(size_t)(t + 1) * DM] = (bf16)(a >> 16); op[(size_t)(t + 2) * DM] = (bf16)(bq & 0xffffu); op[(size_t)(t + 3) * DM] = (bf16)(bq >> 16); }
    }
    __syncthreads();
}
__device__ __forceinline__ void hyena_parts(LAS unsigned char* lds, PK P, int l, int vcu, int G, bool last) {
    int tid_ = threadIdx.x; asm volatile("" : "+v"(tid_)); const int tid = tid_;
    const int ppc = last ? 1 : 2;
    const int nchan = (vcu < 512) ? (512 - vcu + G - 1) / G : 0, np = nchan * ppc;
    if (np == 0) return;
    HyRegs cur, nxt;
    hy_load(cur, P, l, vcu, false, tid);
    for (int p = 0; p < np; ++p) {
        const int c = vcu + G * (p / ppc); const bool isctx = (p % ppc) == 1;
        if (p + 1 < np) hy_load(nxt, P, l, vcu + G * ((p + 1) / ppc), ((p + 1) % ppc) == 1, tid);
        hyena_compute(lds, P, cur, l, c, isctx);
        cur = nxt;
    }
}
__device__ __forceinline__ void pool_unit(PK P, LAS unsigned char* lds, int l, int rb, int g) {
    int tid_ = threadIdx.x; asm volatile("" : "+v"(tid_)); const int tid = tid_, lane = tid & 63, wid = rfl(tid >> 6), tok = lane & 15, kg = lane >> 4;
    const bf16* PL = (const bf16*)(P->ws + WS_PL); bf16* MIXA = (bf16*)(P->ws + WS_MIXA);
    const bf16* PWT = (const bf16*)(P->ws + WS_W + (size_t)l * LW_SIZE + LW_PWT) + (size_t)g * 128 * 128;
    const float* psc = P->in[I_PSCALE] + (size_t)l * PWD + g * 128;
    u32x4 wst[4];
#pragma unroll
    for (int i = 0; i < 4; ++i) wst[i] = *(const u32x4*)(PWT + (size_t)(tid >> 2) * 128 + ((tid & 3) * 4 + i) * 8);
    const int row = rb * 128 + wid * 16 + tok;
    const int sb = (row < RX) ? (row & ~(SEQ - 1)) : (RX + ((row - RX) & ~(CTX - 1))), Ls = (row < RX) ? SEQ : CTX, t = row - sb;
    const int hw = 1 << g;
    const int lo = max(t - hw, 0), hi = min(t + hw, Ls);
    const float invc = 1.f / (float)(hi - lo);
    bf16x8 xf[4];
#pragma unroll
    for (int ks = 0; ks < 4; ++ks) {
        const bf16* cp = PL + (size_t)sb * PWD + g * 128 + 32 * ks + 8 * kg;
        float s[8] = {0.f, 0.f, 0.f, 0.f, 0.f, 0.f, 0.f, 0.f};
        u32x4 c = {0u, 0u, 0u, 0u};
#define PW_LOOP(W) do { u32x4 v_[W]; \
            _Pragma("unroll") for (int q = 0; q < (W); ++q) { const int r_ = t - (W) / 2 + q; const int rc_ = min(max(r_, 0), Ls - 1); v_[q] = *(const u32x4*)(cp + (size_t)rc_ * PWD); } \
            __builtin_amdgcn_sched_barrier(0); \
            _Pragma("unroll") for (int q = 0; q < (W); ++q) { const int r_ = t - (W) / 2 + q; const float f_ = (r_ >= 0 && r_ < Ls) ? 1.f : 0.f; \
                s[0] += f_ * bflo(v_[q].x); s[1] += f_ * bfhi(v_[q].x); s[2] += f_ * bflo(v_[q].y); s[3] += f_ * bfhi(v_[q].y); s[4] += f_ * bflo(v_[q].z); s[5] += f_ * bfhi(v_[q].z); s[6] += f_ * bflo(v_[q].w); s[7] += f_ * bfhi(v_[q].w); } \
            c = v_[(W) / 2]; } while (0)
        if (g == 0) PW_LOOP(2); else if (g == 1) PW_LOOP(4); else if (g == 2) PW_LOOP(8); else PW_LOOP(16);
#undef PW_LOOP
        u32x4 o; o.x = pkbf(s[0] * invc - bflo(c.x), s[1] * invc - bfhi(c.x)); o.y = pkbf(s[2] * invc - bflo(c.y), s[3] * invc - bfhi(c.y));
        o.z = pkbf(s[4] * invc - bflo(c.z), s[5] * invc - bfhi(c.z)); o.w = pkbf(s[6] * invc - bflo(c.w), s[7] * invc - bfhi(c.w));
        xf[ks] = __builtin_bit_cast(bf16x8, o);
    }
#pragma unroll
    for (int i = 0; i < 4; ++i) *(LAS u32x4*)(lds + (tid >> 2) * 272 + ((tid & 3) * 4 + i) * 16) = wst[i];
    __syncthreads();
    f32x4 scv[8];
#pragma unroll
    for (int nbk = 0; nbk < 8; ++nbk) scv[nbk] = *(const f32x4*)(psc + nbk * 16 + 4 * kg);
    __builtin_amdgcn_sched_barrier(0);
#pragma unroll
    for (int nbk = 0; nbk < 8; ++nbk) {
        f32x4 acc = {0.f, 0.f, 0.f, 0.f};
#pragma unroll
        for (int ks = 0; ks < 4; ++ks) { const bf16x8 wf = *(const LAS bf16x8*)(lds + (nbk * 16 + tok) * 272 + (32 * ks + 8 * kg) * 2);
            acc = __builtin_amdgcn_mfma_f32_16x16x32_bf16(wf, xf[ks], acc, 0, 0, 0); }
        const int n0 = nbk * 16 + 4 * kg; const f32x4 sc = scv[nbk];
        u32x2 w; w.x = pkbf(acc[0] * sc.x, acc[1] * sc.y); w.y = pkbf(acc[2] * sc.z, acc[3] * sc.w);
        *(u32x2*)(MIXA + (size_t)row * DM + 1536 + g * 128 + n0) = w;
    }
    __syncthreads();
}

constexpr int NPHASE = 2 + 9 * DEPTH;
constexpr int CV1 = 0, CV2 = 1817, CV3 = 1817, CV4 = 2017;
#ifndef DUPM
#define DUPM 0
#endif
#ifndef DUPB
#define DUPB 0
#endif
__global__ void __launch_bounds__(NTHR, 2) mk_fwd(Params Pv) {
    extern __shared__ __attribute__((aligned(16))) unsigned char lds_raw[];
    LAS unsigned char* lds = (LAS unsigned char*)lds_raw;
    const int G = gridDim.x, bx = blockIdx.x, vcu = (G % 8 == 0) ? (bx % 8) * (G / 8) + bx / 8 : bx;
    const int ph_lo = Pv.ph_lo, ph_hi = Pv.ph_hi;
    if (threadIdx.x < 64) ((LAS unsigned*)(lds + MISC_OFF))[threadIdx.x] = 0u;
    __syncthreads();
    XcdBarrier bar; bar.bar = (unsigned*)(Pv.ws + WS_CTL) + 4096; bar.x = 0; bar.st = nullptr;
    if (ph_hi - ph_lo > 1) bar = xcd_barrier_post((unsigned*)(Pv.ws + WS_CTL) + 4096, (volatile LAS unsigned*)(lds + MISC_OFF) + 8);
#define RUN(p) (ph_lo <= (p) && (p) < ph_hi)
#define SEAM(p) do { if (RUN(p) && RUN((p) + 1)) { xcd_barrier(bar); if (DUPB) xcd_barrier(bar); } } while (0)
#define REP(bit) for (int rep_ = 0; rep_ < (((DUPM) >> (bit)) & 1) + 1; ++rep_)
#define PH_VARS PK P = pk_get(); unsigned char* ws = P->ws; unsigned char* lw = ws + WS_W + (size_t)l * LW_SIZE; const float* ada = (const float*)(ws + WS_ADA) + (size_t)l * 5 * 12288; const float* ng = P->in[I_NORMG] + (size_t)l * 4 * DM; (void)lw; (void)ada; (void)ng

    if (RUN(0)) REP(0) { PK P = pk_get(); prologue_phase(P, lds, vcu, G); __syncthreads(); }
    SEAM(0);
    if (RUN(1)) {
        PK P = pk_get(); const float* ada0 = (const float*)(P->ws + WS_ADA);
        norm_phase<0>(P, vcu, G, RT, ada0, 0, nullptr, nullptr, nullptr, true, ada0, 0, 1, P->in[I_NORMG]);
    }
    SEAM(1);

    for (int l = 0; l < DEPTH; ++l) {
        const int pb = 2 + 9 * l;
        const bool last = (l == DEPTH - 1);
        const int MR = last ? RX : RT;
        if (RUN(pb)) { PH_VARS;
            pg8::Gemm g{(const pg8::bf16_t*)(ws + WS_H), (const pg8::bf16_t*)(lw + LW_WIN), MR, INW, DM, DM, DM};
            OrderX S; S.base.init(MR, INW, G, bx); S.extra = last ? 32 : 0;
            EpiG1 E{(bf16*)(ws + WS_QKV), (bf16*)(ws + WS_HYT), (bf16*)(ws + WS_PL), (bf16*)(ws + WS_GT), (const float*)(ws + WS_ROPE), (const float*)(ws + WS_ROPE) + 1024};
            REP(1) pg8::gemm_phase<EpiG1, OrderX, true, true>(lds, g, S, E);
            if (!last) { const int r = S.base.nwg % G; if (bx >= r) { ada_items(P, lds, l + 1, bx - r, G - r); conv_items(P, lds, l + 1, 0, CV1, bx - r, G - r); } }
        }
        SEAM(pb);
        if (RUN(pb + 1)) { PH_VARS;
            const float* sc = (const float*)(ws + WS_SC) + 2 * l;
            const float lam = sc[0], oscale = sc[1];
            const float* subg = P->in[I_SUBG] + (size_t)l * 128;
            REP(2) for (int u = vcu; u < 512; u += G) attn_unit(lds, (const bf16*)(ws + WS_QKV), (bf16*)(ws + WS_MIXA), lam, oscale, subg, u >> 7, (u >> 4) & 7, u & 15, false);
            REP(3) hyena_parts(lds, P, l, vcu, G, last);
            REP(2) if (!last) for (int u = vcu; u < 64; u += G) attn_unit(lds, (const bf16*)(ws + WS_QKV), (bf16*)(ws + WS_MIXA), lam, oscale, subg, u >> 4, (u >> 1) & 7, u & 1, true);
            const int npool = (MR >> 7) * 4;
            REP(4) for (int u = (vcu + G - 64 % G) % G; u < npool; u += G) pool_unit(P, lds, l, u >> 2, u & 3);
            if (!last) conv_items(P, lds, l + 1, CV4, CONV_ALL, vcu, G);
        }
        SEAM(pb + 1);
        if (RUN(pb + 2)) { PH_VARS; REP(5) {
            pg8::Gemm g{(const pg8::bf16_t*)(ws + WS_MIXA), (const pg8::bf16_t*)(lw + LW_WAO), MR, DM, 512, DM, DM};
            OrderG2 S; S.ctx2 = !last && G == 256; S.base.init(S.ctx2 ? RX : MR, DM, G, bx); if (S.ctx2) S.init2();
            EpiG2 E{(const bf16*)(ws + WS_GT), (bf16*)(ws + WS_MERGED)};
            pg8::gemm_phase<EpiG2, OrderG2, true, true>(lds, g, S, E);
            if (!last) {
                if (S.ctx2) { const int wg = (S.pm0 >> 3) * 64 + S.pn0 * 8 + (S.pm0 & 7);
                    if (S.pm1 < 0) conv_items(P, lds, l + 1, CV1, CV2, wg - (wg >> 3) - 1, 224); }
                else { const int r = S.base.nwg % G; if (bx >= r) conv_items(P, lds, l + 1, CV1, CV2, bx - r, G - r); }
            }
        } }
        SEAM(pb + 2);
        if (RUN(pb + 3)) { PH_VARS; REP(6) {
            pg8::Gemm g{(const pg8::bf16_t*)(ws + WS_MERGED), (const pg8::bf16_t*)(lw + LW_WOUT), RX, DM, DM, DM, DM};
            OrderLatCtx S; S.init(RX, DM, G, bx); S.ctx = !last; S.sp = SplitOrder{128, 4, 512, G, (bx + G / 2) % G};
            EpiPlainSlab E{EpiPlain{(bf16*)(ws + WS_MIX), DM}, EpiSlab{(float*)(ws + WS_SLAB)}};
            pg8::gemm_phase<EpiPlainSlab, OrderLatCtx, true, true>(lds, g, S, E);
        } }
        SEAM(pb + 3);
        if (RUN(pb + 4)) { PH_VARS; norm_phase<1>(P, vcu, G, MR, ada, 2, ng + DM, (const bf16*)(ws + WS_MIX), nullptr, true, ada, 3, 4, ng + 2 * DM, (const float*)(ws + WS_SLAB), last ? 0 : 4); }
        SEAM(pb + 4);
        if (RUN(pb + 5)) { PH_VARS;
            pg8::Gemm g{(const pg8::bf16_t*)(ws + WS_H), (const pg8::bf16_t*)(lw + LW_WUP), MR, INW, DM, DM, DM};
            OrderX S; S.base.init(MR, INW, G, bx); S.extra = 0;
            EpiG4F E{(bf16*)(ws + WS_ACT), (bf16*)(ws + WS_EG), (bf16*)(ws + WS_EV), P->in[I_FFCW] + (size_t)l * 3 * FF};
            REP(7) pg8::gemm_phase<EpiG4F, OrderX, true, true>(lds, g, S, E);
            if (!last) { const int r = S.base.nwg % G; if (bx >= r) { filter_items(P, lds, l + 1, bx - r, G - r); conv_items(P, lds, l + 1, CV2, CV3, bx - r, G - r); } }
        }
        SEAM(pb + 5);
        if (RUN(pb + 6)) REP(8) { PH_VARS; act_edge_phase(P, vcu, G, MR, P->in[I_FFCW] + (size_t)l * 3 * FF); }
        SEAM(pb + 6);
        if (RUN(pb + 7)) { PH_VARS; REP(9) {
            pg8::Gemm g{(const pg8::bf16_t*)(ws + WS_ACT), (const pg8::bf16_t*)(lw + LW_WDN), RX, DM, FF, FF, FF};
            OrderLatCtx S; S.init(RX, DM, G, bx); S.ctx = !last; S.sp = SplitOrder{128, 4, 1408, G, bx};
            EpiPlainSlab E{EpiPlain{(bf16*)(ws + WS_MIX), DM}, EpiSlab{(float*)(ws + WS_SLAB)}};
            pg8::gemm_phase<EpiPlainSlab, OrderLatCtx, true, true>(lds, g, S, E);
            if (!last && bx >= 128) conv_items(P, lds, l + 1, CV3, CV4, bx - 128, G - 128);
        } }
        SEAM(pb + 7);
        if (RUN(pb + 8)) { PH_VARS;
            if (!last) norm_phase<1>(P, vcu, G, RT, ada, 5, ng + 3 * DM, (const bf16*)(ws + WS_MIX), nullptr, true, ada + 5 * 12288, 0, 1, ng + 4 * DM, (const float*)(ws + WS_SLAB), 4);
            else norm_phase<1>(P, vcu, G, RX, ada, 5, ng + 3 * DM, (const bf16*)(ws + WS_MIX), P->out, false, ada, 0, 1, ng);
        }
        if (!last) SEAM(pb + 8);
    }
#undef RUN
#undef SEAM
#undef REP
#undef PH_VARS
}

extern "C" void kernel_launch(void* const* d_in, const int* in_sizes, int n_in, void* d_out, int out_size, void* d_ws, size_t ws_size, hipStream_t stream) {
    static int grid = 0;
    if (grid == 0) {
        if (n_in != 27 || out_size != RX * DM || ws_size < WS_END) { fprintf(stderr, "kernel_launch: unexpected problem shape (n_in %d, out %d, ws %zu < %zu)\n", n_in, out_size, ws_size, (size_t)WS_END); grid = -1; return; }
        int dev = 0, cus = 0;
        if (hipGetDevice(&dev) != hipSuccess || hipDeviceGetAttribute(&cus, hipDeviceAttributeMultiprocessorCount, dev) != hipSuccess || cus <= 0) { grid = -1; return; }
        if (hipFuncSetAttribute((const void*)mk_fwd, hipFuncAttributeMaxDynamicSharedMemorySize, LDS_BYTES) != hipSuccess) { fprintf(stderr, "kernel_launch: hipFuncSetAttribute failed\n"); grid = -1; return; }
        int per_cu = 0;
        if (hipOccupancyMaxActiveBlocksPerMultiprocessor(&per_cu, (const void*)mk_fwd, NTHR, LDS_BYTES) != hipSuccess || per_cu < 1) fprintf(stderr, "kernel_launch: occupancy query reports %d blocks per CU\n", per_cu);
        (void)hipGetLastError();
        grid = cus;
    }
    if (grid < 0) return;
    if (hipMemsetAsync((char*)d_ws + WS_CTL, 0, CTL_ZERO, stream) != hipSuccess) return;
    Params p{};
    for (int i = 0; i < 27; ++i) p.in[i] = (const float*)d_in[i];
    p.out = (float*)d_out; p.ws = (unsigned char*)d_ws;
    p.ph_lo = 0; p.ph_hi = NPHASE;
    hipLaunchKernelGGL(mk_fwd, dim3(grid), dim3(NTHR), LDS_BYTES, stream, p);
}
```
